# Optimizing an MI355X kernel written in HIP

```python
import math
import jax, jax.numpy as jnp
from jax import lax
import numpy as np

D_MODEL = 1024
BATCH = 32
SEQ = 256
DEPTH = 4
DEC_BATCH = 2
DEC_SEQ = 1024
PAST_LEN = 256

GRID_W = 64
N_MIXERS = 4
N_GLA_L = len(range(0, DEPTH, N_MIXERS))
N_NAT_L = len(range(1, DEPTH, N_MIXERS))
N_GM_L = len(range(2, DEPTH, N_MIXERS))
N_SSD_L = len(range(3, DEPTH, N_MIXERS))
N_SUB = 3
N_MOD = 3 * N_SUB
D_FF = 2816
EPS = 1e-6
NEG_INF = -1e30
ROPE_THETA = 10000.0
GLA_H = 4
GLA_DK = 128
GLA_DV = 256
GLA_RANK = 16
GLA_TAU = 16.0
GLA_CHUNK = 16
GLA_IN = 2 * GLA_H * GLA_DK + 2 * GLA_H * GLA_DV
NAT_H = 16
NAT_HD = 64
NAT_WH = 8
NAT_WW = 16
NAT_QB = 16
NAT_KB = 32
GM_DH = 1024
GM_G = 8
GM_CHUNK = 128
GM_CG = GM_DH // GM_G
SSD_DI = 2 * D_MODEL
SSD_P = 64
SSD_H = SSD_DI // SSD_P
SSD_N = 128
SSD_G = 4
SSD_CONV = 3
SSD_CHUNK = 64
SSD_XBC = SSD_DI + 2 * SSD_G * SSD_N
SSD_IN = SSD_DI + SSD_XBC + 2 * SSD_H

kernel_name = "hybrid_flow_trunk_prefix_ctx"


def rmsnorm(x, g):
    x32 = x.astype(jnp.float32)
    y = x32 * lax.rsqrt(jnp.mean(x32 * x32, axis=-1, keepdims=True) + EPS)
    return y.astype(x.dtype) * g


def layernorm(x, g, b):
    x32 = x.astype(jnp.float32)
    xc = x32 - jnp.mean(x32, axis=-1, keepdims=True)
    y = xc * lax.rsqrt(jnp.mean(xc * xc, axis=-1, keepdims=True) + EPS)
    return y.astype(x.dtype) * g + b


def modulation(cond, w_ada, b_ada):
    m = jax.nn.silu(cond) @ w_ada + b_ada
    return m.reshape(cond.shape[0], N_MOD, D_MODEL)


def pre_mod(x, g, mod, k):
    shift = mod[:, 3 * k][:, None]
    scale = mod[:, 3 * k + 1][:, None]
    gate = mod[:, 3 * k + 2][:, None]
    return rmsnorm(x, g) * (1.0 + scale) + shift, gate


def swiglu(h, w_in, w_out):
    a, u = jnp.split(h @ w_in, 2, axis=-1)
    return (jax.nn.silu(a) * u) @ w_out


def rope_2d(x):
    T, dh = x.shape[1], x.shape[-1]
    half = dh // 2
    t = jnp.arange(T)
    inv = ROPE_THETA ** (-jnp.arange(0, half, 2, dtype=jnp.float32) / half)

    def rot(xa, pos):
        ang = pos.astype(jnp.float32)[:, None] * inv
        cos = jnp.cos(ang)[None, :, None, :]
        sin = jnp.sin(ang)[None, :, None, :]
        x1, x2 = jnp.split(xa.astype(jnp.float32), 2, axis=-1)
        return jnp.concatenate([x1 * cos - x2 * sin, x1 * sin + x2 * cos], axis=-1)

    out = jnp.concatenate([rot(x[..., :half], t // GRID_W), rot(x[..., half:], t % GRID_W)], axis=-1)
    return out.astype(x.dtype)


def flip_t(t):
    return jnp.flip(t, axis=1)


def gla_chunked(q, k, v, log_a, s0):
    B_, T, H, _ = q.shape
    dv = v.shape[-1]
    C = GLA_CHUNK
    n = T // C

    def blk(t):
        return t.astype(jnp.float32).reshape(B_, n, C, H, -1).transpose(0, 1, 3, 2, 4)

    q, k, v, la = blk(q), blk(k), blk(v), blk(log_a)
    b = jnp.cumsum(la, axis=3)
    tril = jnp.tril(jnp.ones((C, C), dtype=bool))
    diff = b[:, :, :, :, None, :] - b[:, :, :, None, :, :]
    decay = jnp.exp(jnp.where(tril[:, :, None], diff, -jnp.inf))
    attn = jnp.einsum('bnhid,bnhjd,bnhijd->bnhij', q, k, decay)
    o_intra = jnp.einsum('bnhij,bnhjv->bnhiv', attn, v)
    b_last = b[:, :, :, -1:, :]
    q_dec = q * jnp.exp(b)
    u = jnp.einsum('bnhjd,bnhjv->bnhdv', k * jnp.exp(b_last - b), v)
    g = jnp.exp(b_last[:, :, :, 0])

    def step(s, xs):
        qd, un, gn = xs
        o = jnp.einsum('bhid,bhdv->bhiv', qd, s)
        return gn[..., None] * s + un, o

    s_fin, o_inter = lax.scan(step, s0.astype(jnp.float32),
                              (jnp.swapaxes(q_dec, 0, 1), jnp.swapaxes(u, 0, 1), jnp.swapaxes(g, 0, 1)))
    o = o_intra + jnp.swapaxes(o_inter, 0, 1)
    return o.transpose(0, 1, 3, 2, 4).reshape(B_, T, H, dv), s_fin


def gla_mixer(h, s0, w_in, w_a1, w_a2, b_a, norm_g, w_out, use_rope):
    B_, T, _ = h.shape
    q, k, v, r = jnp.split(h @ w_in, [GLA_H * GLA_DK, 2 * GLA_H * GLA_DK,
                                      2 * GLA_H * GLA_DK + GLA_H * GLA_DV], axis=-1)
    q = q.reshape(B_, T, GLA_H, GLA_DK) * (GLA_DK ** -0.5)
    k = k.reshape(B_, T, GLA_H, GLA_DK)
    v = v.reshape(B_, T, GLA_H, GLA_DV)
    if use_rope:
        q, k = rope_2d(q), rope_2d(k)
    z = jnp.einsum('btd,edr->bter', h, w_a1)
    z = jnp.einsum('bter,erk->btek', z, w_a2) + b_a
    log_a = (jax.nn.log_sigmoid(z.astype(jnp.float32)) / GLA_TAU).reshape(B_, T, 2, GLA_H, GLA_DK)
    o_f, s_f = gla_chunked(q, k, v, log_a[:, :, 0], s0[:, 0])
    o_b, s_b = gla_chunked(flip_t(q), flip_t(k), flip_t(v), flip_t(log_a[:, :, 1]), s0[:, 1])
    o = o_f + flip_t(o_b)
    o = rmsnorm(o, norm_g.reshape(GLA_H, GLA_DV)).astype(h.dtype)
    o = o.reshape(B_, T, GLA_H * GLA_DV) * jax.nn.silu(r)
    return o @ w_out, jnp.stack([s_f, s_b], axis=1)


def nat_tables(rows):
    wh = min(NAT_WH, rows)
    r = np.arange(rows)
    row_idx = np.clip(r - wh // 2, 0, rows - wh)[:, None] + np.arange(wh)
    ncb = GRID_W // NAT_QB
    col_idx = np.clip(np.arange(ncb) * NAT_QB - (NAT_KB - NAT_QB) // 2, 0,
                      GRID_W - NAT_KB)[:, None] + np.arange(NAT_KB)
    qcol = np.arange(ncb)[:, None] * NAT_QB + np.arange(NAT_QB)
    c_start = np.clip(qcol - NAT_WW // 2, 0, GRID_W - NAT_WW)
    kc = col_idx[:, None, :]
    col_ok = (kc >= c_start[..., None]) & (kc < c_start[..., None] + NAT_WW)
    dc = kc - qcol[..., None]
    dr = row_idx - r[:, None]
    full = (rows, ncb, NAT_QB, wh, NAT_KB)
    flat = (rows, ncb, NAT_QB, wh * NAT_KB)
    dr_i = np.broadcast_to(dr[:, None, None, :, None] + NAT_WH - 1, full).reshape(flat)
    dc_i = np.broadcast_to(np.clip(dc + NAT_WW - 1, 0, 2 * NAT_WW - 2)[None, :, :, None, :], full).reshape(flat)
    ok = np.broadcast_to(col_ok[None, :, :, None, :], full).reshape(flat)
    return row_idx, col_idx, dr_i, dc_i, ok


def nat_context(h, w_qkv, w_out):
    B_, S, _ = h.shape
    q, k, v = jnp.split(h @ w_qkv, 3, axis=-1)
    q = q.reshape(B_, S, NAT_H, NAT_HD)
    k = k.reshape(B_, S, NAT_H, NAT_HD)
    v = v.reshape(B_, S, NAT_H, NAT_HD)
    s = jnp.einsum('bqhd,bkhd->bhqk', q, k).astype(jnp.float32) * (NAT_HD ** -0.5)
    p = jax.nn.softmax(s, axis=-1).astype(h.dtype)
    o = jnp.einsum('bhqk,bkhd->bqhd', p, v).reshape(B_, S, D_MODEL)
    return o @ w_out, k.transpose(0, 2, 1, 3), v.transpose(0, 2, 1, 3)


def nat_latent(h, ck, cv, w_qkv, rpb, w_out):
    B_, T, _ = h.shape
    rows = T // GRID_W
    ncb = GRID_W // NAT_QB
    row_idx, col_idx, dr_i, dc_i, ok = nat_tables(rows)
    q, k, v = jnp.split(h @ w_qkv, 3, axis=-1)
    q = q.reshape(B_, rows, ncb, NAT_QB, NAT_H, NAT_HD)
    k = k.reshape(B_, rows, GRID_W, NAT_H, NAT_HD)
    v = v.reshape(B_, rows, GRID_W, NAT_H, NAT_HD)
    ri = row_idx[:, None, :, None]
    ci = col_idx[None, :, None, :]
    kb = k[:, ri, ci].reshape(B_, rows, ncb, -1, NAT_H, NAT_HD)
    vb = v[:, ri, ci].reshape(B_, rows, ncb, -1, NAT_H, NAT_HD)
    nk = kb.shape[3]
    scale = NAT_HD ** -0.5
    s_lat = jnp.einsum('brnqhd,brnkhd->bhrnqk', q, kb).astype(jnp.float32) * scale
    s_lat = s_lat + rpb[:, dr_i, dc_i].astype(jnp.float32)
    s_lat = jnp.where(ok, s_lat, NEG_INF)
    s_ctx = jnp.einsum('brnqhd,bhsd->bhrnqs', q, ck).astype(jnp.float32) * scale
    p = jax.nn.softmax(jnp.concatenate([s_lat, s_ctx], axis=-1), axis=-1).astype(h.dtype)
    o = (jnp.einsum('bhrnqk,brnkhd->brnqhd', p[..., :nk], vb)
         + jnp.einsum('bhrnqs,bhsd->brnqhd', p[..., nk:], cv))
    return o.reshape(B_, T, D_MODEL) @ w_out


def gmlp_mixer(h, w_in, ln_g, ln_b, w_s, b_s, w_out):
    B_, T, _ = h.shape
    u, v = jnp.split(jax.nn.gelu(h @ w_in), 2, axis=-1)
    v = layernorm(v, ln_g, ln_b).reshape(B_, T // GM_CHUNK, GM_CHUNK, GM_G, GM_CG)
    v = jnp.einsum('gpq,bnqgc->bnpgc', w_s, v) + b_s.T[None, None, :, :, None]
    return (u * v.reshape(B_, T, GM_DH)) @ w_out


def dwconv_centred(x, w, b):
    K = w.shape[0]
    T = x.shape[1]
    pad = K // 2
    xp = jnp.pad(x, ((0, 0), (pad, pad), (0, 0)))
    out = xp[:, 0:T] * w[0]
    for i in range(1, K):
        out = out + xp[:, i:i + T] * w[i]
    return out + b


def ssd_chunked(x, dt, a, bm, cm, s0):
    B_, T = x.shape[:2]
    L = SSD_CHUNK
    n = T // L
    E = SSD_H // SSD_G
    f32 = jnp.float32
    x = x.astype(f32).reshape(B_, n, L, SSD_G, E, SSD_P)
    dt = dt.reshape(B_, n, L, SSD_G, E)
    bm = bm.astype(f32).reshape(B_, n, L, SSD_G, SSD_N)
    cm = cm.astype(f32).reshape(B_, n, L, SSD_G, SSD_N)
    cum = jnp.cumsum(dt * a.reshape(SSD_G, E), axis=2)
    tril = jnp.tril(jnp.ones((L, L), dtype=bool))
    seg = cum[:, :, :, None] - cum[:, :, None, :]
    decay = jnp.exp(jnp.where(tril[:, :, None, None], seg, -jnp.inf))
    dtx = x * dt[..., None]
    cb = jnp.einsum('bnigs,bnjgs->bnijg', cm, bm)
    y_diag = jnp.einsum('bnijg,bnijge,bnjgep->bnigep', cb, decay, dtx)
    u = jnp.einsum('bnjgs,bnjge,bnjgep->bngeps', bm, jnp.exp(cum[:, :, -1:] - cum), dtx)
    chunk_decay = jnp.exp(cum[:, :, -1])
    q_decay = jnp.exp(cum)

    def step(s, xs):
        c_n, qd_n, u_n, g_n = xs
        y = jnp.einsum('bigs,bige,bgeps->bigep', c_n, qd_n, s)
        return g_n[..., None, None] * s + u_n, y

    sw = lambda t: jnp.swapaxes(t, 0, 1)
    s_fin, y_off = lax.scan(step, s0.astype(f32).reshape(B_, SSD_G, E, SSD_P, SSD_N),
                            (sw(cm), sw(q_decay), sw(u), sw(chunk_decay)))
    y = y_diag + sw(y_off)
    return y.reshape(B_, T, SSD_H, SSD_P), s_fin.reshape(B_, SSD_H, SSD_P, SSD_N)


def ssd_mixer(h, s0, w_in, conv_w, conv_b, dt_bias, a_log, d_skip, norm_g, w_out):
    B_, T, _ = h.shape
    z, xbc, dt = jnp.split(h @ w_in, [SSD_DI, SSD_DI + SSD_XBC], axis=-1)
    xbc = jax.nn.silu(dwconv_centred(xbc, conv_w, conv_b))
    x, bm, cm = jnp.split(xbc, [SSD_DI, SSD_DI + SSD_G * SSD_N], axis=-1)
    x = x.reshape(B_, T, SSD_H, SSD_P)
    bm = bm.reshape(B_, T, SSD_G, SSD_N)
    cm = cm.reshape(B_, T, SSD_G, SSD_N)
    dt = jax.nn.softplus(dt.astype(jnp.float32).reshape(B_, T, 2, SSD_H) + dt_bias)
    a = -jnp.exp(a_log.astype(jnp.float32))
    y_f, s_f = ssd_chunked(x, dt[:, :, 0], a[0], bm, cm, s0[:, 0])
    y_b, s_b = ssd_chunked(flip_t(x), flip_t(dt[:, :, 1]), a[1], flip_t(bm), flip_t(cm), s0[:, 1])
    y = y_f + flip_t(y_b) + d_skip[:, None] * x.astype(jnp.float32)
    y = rmsnorm(y.reshape(B_, T, SSD_DI) * jax.nn.silu(z.astype(jnp.float32)), norm_g).astype(h.dtype)
    return y @ w_out, jnp.stack([s_f, s_b], axis=1)


def setup_inputs(seed: int = 0) -> dict:
    key = jax.random.key(seed)
    keys = iter(jax.random.split(key, 64))

    def nrm(shape, scale):
        return scale * jax.random.normal(next(keys), shape, jnp.float32)

    def unif(shape, lo, hi):
        return jax.random.uniform(next(keys), shape, jnp.float32, lo, hi)

    D = D_MODEL
    dt0 = jnp.exp(unif((N_SSD_L, 2, SSD_H), math.log(1e-3), math.log(1e-1)))
    return {
        'x_prompt': nrm((BATCH, SEQ, D), 1.0),
        'x_sample': nrm((DEC_BATCH, DEC_SEQ, D), 1.0),
        'state_gla': nrm((DEC_BATCH, N_GLA_L, 2, GLA_H, GLA_DK, GLA_DV), 0.1),
        'cache_nat_k': nrm((DEC_BATCH, N_NAT_L, NAT_H, PAST_LEN, NAT_HD), 1.0),
        'cache_nat_v': nrm((DEC_BATCH, N_NAT_L, NAT_H, PAST_LEN, NAT_HD), 1.0),
        'state_ssd': nrm((DEC_BATCH, N_SSD_L, 2, SSD_H, SSD_P, SSD_N), 0.1),
        'c': nrm((DEC_BATCH, D), 1.0),
        'c_ctx': nrm((D,), 1.0),
        'norm_g': 1.0 + nrm((DEPTH, N_SUB, D), 0.02),
        'w_ada': nrm((DEPTH, D, N_MOD * D), 0.5 * D ** -0.5),
        'b_ada': nrm((DEPTH, N_MOD * D), 0.02),
        'w_ffn_in': nrm((DEPTH, 2, D, 2 * D_FF), D ** -0.5),
        'w_ffn_out': nrm((DEPTH, 2, D_FF, D), D_FF ** -0.5),
        'gla_w_in': nrm((N_GLA_L, D, GLA_IN), D ** -0.5),
        'gla_w_a1': nrm((N_GLA_L, 2, D, GLA_RANK), D ** -0.5),
        'gla_w_a2': nrm((N_GLA_L, 2, GLA_RANK, GLA_H * GLA_DK), GLA_RANK ** -0.5),
        'gla_b_a': nrm((N_GLA_L, 2, GLA_H * GLA_DK), 0.5),
        'gla_norm_g': 1.0 + nrm((N_GLA_L, GLA_H * GLA_DV), 0.02),
        'gla_w_out': nrm((N_GLA_L, GLA_H * GLA_DV, D), (GLA_H * GLA_DV) ** -0.5),
        'nat_w_qkv': nrm((N_NAT_L, D, 3 * D), D ** -0.5),
        'nat_rpb': nrm((N_NAT_L, NAT_H, 2 * NAT_WH - 1, 2 * NAT_WW - 1), 0.02),
        'nat_w_out': nrm((N_NAT_L, D, D), D ** -0.5),
        'gm_w_in': nrm((N_GM_L, D, 2 * GM_DH), D ** -0.5),
        'gm_ln_g': 1.0 + nrm((N_GM_L, GM_DH), 0.02),
        'gm_ln_b': nrm((N_GM_L, GM_DH), 0.02),
        'gm_w_s': nrm((N_GM_L, GM_G, GM_CHUNK, GM_CHUNK), GM_CHUNK ** -0.5),
        'gm_b_s': 1.0 + nrm((N_GM_L, GM_G, GM_CHUNK), 0.02),
        'gm_w_out': nrm((N_GM_L, GM_DH, D), GM_DH ** -0.5),
        'ssd_w_in': nrm((N_SSD_L, D, SSD_IN), D ** -0.5),
        'ssd_conv_w': nrm((N_SSD_L, SSD_CONV, SSD_XBC), SSD_CONV ** -0.5),
        'ssd_conv_b': nrm((N_SSD_L, SSD_XBC), 0.02),
        'ssd_dt_bias': dt0 + jnp.log(-jnp.expm1(-dt0)),
        'ssd_a_log': jnp.log(unif((N_SSD_L, 2, SSD_H), 1.0, 16.0)),
        'ssd_d': 1.0 + nrm((N_SSD_L, SSD_H), 0.1),
        'ssd_norm_g': 1.0 + nrm((N_SSD_L, SSD_DI), 0.02),
        'ssd_w_out': nrm((N_SSD_L, SSD_DI, D), SSD_DI ** -0.5),
        'final_g': 1.0 + nrm((D,), 0.02),
    }


def reference(x_prompt, x_sample, state_gla, cache_nat_k, cache_nat_v, state_ssd, c,
              c_ctx, norm_g, w_ada, b_ada, w_ffn_in, w_ffn_out,
              gla_w_in, gla_w_a1, gla_w_a2, gla_b_a, gla_norm_g, gla_w_out,
              nat_w_qkv, nat_rpb, nat_w_out,
              gm_w_in, gm_ln_g, gm_ln_b, gm_w_s, gm_b_s, gm_w_out,
              ssd_w_in, ssd_conv_w, ssd_conv_b, ssd_dt_bias, ssd_a_log, ssd_d, ssd_norm_g, ssd_w_out,
              final_g):
    xp, xs = x_prompt, x_sample
    new_gla, new_k, new_v, new_ssd = [], [], [], []
    for l in range(DEPTH):
        kind, j = l % N_MIXERS, l // N_MIXERS
        mp = modulation(c_ctx[None], w_ada[l], b_ada[l])
        ms = modulation(c, w_ada[l], b_ada[l])
        hp, gp = pre_mod(xp, norm_g[l, 0], mp, 0)
        hs, gs = pre_mod(xs, norm_g[l, 0], ms, 0)
        xp = xp + 0.5 * gp * swiglu(hp, w_ffn_in[l, 0], w_ffn_out[l, 0])
        xs = xs + 0.5 * gs * swiglu(hs, w_ffn_in[l, 0], w_ffn_out[l, 0])
        hp, gp = pre_mod(xp, norm_g[l, 1], mp, 1)
        hs, gs = pre_mod(xs, norm_g[l, 1], ms, 1)
        if kind == 0:
            zero_state = jnp.zeros((hp.shape[0], 2, GLA_H, GLA_DK, GLA_DV), jnp.float32)
            op, st = gla_mixer(hp, zero_state, gla_w_in[j], gla_w_a1[j], gla_w_a2[j], gla_b_a[j],
                               gla_norm_g[j], gla_w_out[j], False)
            os_, _ = gla_mixer(hs, state_gla[:, j], gla_w_in[j], gla_w_a1[j], gla_w_a2[j], gla_b_a[j],
                               gla_norm_g[j], gla_w_out[j], True)
            new_gla.append(st)
        elif kind == 1:
            op, kc, vc = nat_context(hp, nat_w_qkv[j], nat_w_out[j])
            os_ = nat_latent(hs, cache_nat_k[:, j], cache_nat_v[:, j], nat_w_qkv[j], nat_rpb[j], nat_w_out[j])
            new_k.append(kc)
            new_v.append(vc)
        elif kind == 2:
            op = gmlp_mixer(hp, gm_w_in[j], gm_ln_g[j], gm_ln_b[j], gm_w_s[j], gm_b_s[j], gm_w_out[j])
            os_ = gmlp_mixer(hs, gm_w_in[j], gm_ln_g[j], gm_ln_b[j], gm_w_s[j], gm_b_s[j], gm_w_out[j])
        else:
            zero_state = jnp.zeros((hp.shape[0], 2, SSD_H, SSD_P, SSD_N), jnp.float32)
            op, st = ssd_mixer(hp, zero_state, ssd_w_in[j], ssd_conv_w[j], ssd_conv_b[j], ssd_dt_bias[j],
                               ssd_a_log[j], ssd_d[j], ssd_norm_g[j], ssd_w_out[j])
            os_, _ = ssd_mixer(hs, state_ssd[:, j], ssd_w_in[j], ssd_conv_w[j], ssd_conv_b[j], ssd_dt_bias[j],
                               ssd_a_log[j], ssd_d[j], ssd_norm_g[j], ssd_w_out[j])
            new_ssd.append(st)
        xp = xp + gp * op
        xs = xs + gs * os_
        hp, gp = pre_mod(xp, norm_g[l, 2], mp, 2)
        hs, gs = pre_mod(xs, norm_g[l, 2], ms, 2)
        xp = xp + 0.5 * gp * swiglu(hp, w_ffn_in[l, 1], w_ffn_out[l, 1])
        xs = xs + 0.5 * gs * swiglu(hs, w_ffn_in[l, 1], w_ffn_out[l, 1])
    y_prompt = rmsnorm(xp, final_g)
    y_sample = rmsnorm(xs, final_g)
    return (y_prompt, y_sample, jnp.stack(new_gla, axis=1), jnp.stack(new_k, axis=1),
            jnp.stack(new_v, axis=1), jnp.stack(new_ssd, axis=1))
```

```cpp
#include <hip/hip_runtime.h>
#include <cstdio>
#include <cstdint>

#ifndef MK_PER_PHASE
#define MK_PER_PHASE 0
#endif

#define LAS __attribute__((address_space(3)))
typedef unsigned short bf16;
typedef short bf16x8 __attribute__((ext_vector_type(8)));
typedef short bf16x4 __attribute__((ext_vector_type(4)));
typedef float f32x4 __attribute__((ext_vector_type(4)));
typedef float f32x2 __attribute__((ext_vector_type(2)));
typedef unsigned u32x4 __attribute__((ext_vector_type(4)));
typedef unsigned u32x2 __attribute__((ext_vector_type(2)));

typedef __bf16 hwbf16x2 __attribute__((ext_vector_type(2)));
__device__ __forceinline__ unsigned f2bf(float f) { return (unsigned)__builtin_bit_cast(unsigned short, (__bf16)f); }
__device__ __forceinline__ unsigned pk2(float lo, float hi) { const hwbf16x2 v = {(__bf16)lo, (__bf16)hi}; return __builtin_bit_cast(unsigned, v); }
__device__ __forceinline__ unsigned f2bf_sw(float f) { unsigned u = __builtin_bit_cast(unsigned, f); return (u + 0x7fffu + ((u >> 16) & 1u)) >> 16; }
__device__ __forceinline__ unsigned pk2_sw(float lo, float hi) { return f2bf_sw(lo) | (f2bf_sw(hi) << 16); }
__device__ __forceinline__ float bf2f(unsigned b) { return __builtin_bit_cast(float, b << 16); }
__device__ __forceinline__ float bflo(unsigned w) { return __builtin_bit_cast(float, w << 16); }
__device__ __forceinline__ float bfhi(unsigned w) { return __builtin_bit_cast(float, w & 0xffff0000u); }
__device__ __forceinline__ float fast_rcp(float x) { return __builtin_amdgcn_rcpf(x); }
__device__ __forceinline__ float silu_f(float a) { return a * fast_rcp(1.0f + __expf(-a)); }
__device__ __forceinline__ float wave_sum(float v) {
#pragma unroll
    for (int o = 1; o < 64; o <<= 1) v += __shfl_xor(v, o);
    return v;
}

constexpr int D = 1024, NCTX = 8192, NLAT = 2048, M = NCTX + NLAT, DFF = 2816, NMOD = 9216;
constexpr int GLA_NP = 3328, SSD_NP = 5376;

namespace pg8 {
constexpr int BM = 256, BK = 64, HALF = 128, HTB = HALF * BK * 2, STAGE_BYTES = 8 * HTB, NXCD = 8, WGM = 8;
__host__ __device__ __forceinline__ int lds_byte(int r, int c) { const int st = (r >> 4) * 2 + (c >> 5), rr = r & 15, cc = c & 31, ob = rr * 64 + cc * 2; return st * 1024 + (ob ^ (((ob >> 9) & 1) << 5)); }
__host__ __device__ __forceinline__ void stage_rc(int b, int& R, int& C) { const int st = b / 1024, sb = b % 1024, swz = sb ^ (((sb >> 9) & 1) << 5); R = (st >> 1) * 16 + swz / 64; C = (st & 1) * 32 + (swz % 64) / 2; }
__host__ __device__ __forceinline__ int perm32(int rho) { const int n = rho >> 4, i = rho & 15; return 8 * (i >> 2) + 4 * n + (i & 3); }
struct Unit { int pm, pn, nb, bsel; };
struct Gemm { const bf16* A; const bf16* Bt; int M, N, K; };
struct TileOrder {
    int nM, nN, nwg, G, c, nfull, R; bool halves, thin;
    __host__ __device__ __forceinline__ void init(int M_, int N_, int G_, int c_, bool half_ok, bool thin_ = false) { nM = M_ / BM; nN = N_ / BM; thin = thin_ && half_ok; if (thin) nN -= 1;
        nwg = nM * nN; G = G_; c = c_; nfull = nwg / G; R = nwg - nfull * G; halves = !thin && half_ok && R > 0 && 2 * R <= G; }
    __host__ __device__ __forceinline__ void decode(int L, Unit& u) const {
        int wgid = L; { const int q = nwg / NXCD, r = nwg % NXCD, xcd = wgid % NXCD, off = wgid / NXCD; wgid = (xcd < r ? xcd * (q + 1) : r * (q + 1) + (xcd - r) * q) + off; }
        const int nig = WGM * nN, gid = wgid / nig, fm = gid * WGM, gsz = (nM - fm) < WGM ? (nM - fm) : WGM;
        u.pm = fm + ((wgid % nig) % gsz); u.pn = (wgid % nig) / gsz;
    }
    __host__ __device__ __forceinline__ bool next(int i, Unit& u) const {
        if (i < nfull) { decode(i * G + c, u); u.nb = 2; u.bsel = 0; return true; }
        if (thin) { if (i == nfull && c < R) { decode(nfull * G + c, u); u.nb = 2; u.bsel = 0; return true; }
            if (c < R) return false;
            const int t = (c - R) + (i - nfull) * (G - R); if (t >= nM) return false;
            u.pm = t; u.pn = nN; u.nb = 1; u.bsel = 0; return true; }
        if (i > nfull) return false;
        if (halves) { if (c >= 2 * R) return false; decode(nfull * G + (c >> 1), u); u.nb = 1; u.bsel = c & 1; return true; }
        if (c >= R) return false;
        decode(nfull * G + c, u); u.nb = 2; u.bsel = 0; return true;
    }
    __device__ __forceinline__ void a_ready(const Unit&) const {}
    __device__ __forceinline__ void done(const Unit&) const {}
};
template <class Epi, class Sched>
__device__ __forceinline__ void gemm_phase(LAS unsigned char* lds, const Gemm g, const Sched& S, const Epi& E, const int tid) {
    const int wid = __builtin_amdgcn_readfirstlane(tid >> 6), lane = tid & 63, wr = wid >> 2, wc = wid & 3, fr = lane & 15, fq = lane >> 4;
    const int K = g.K, nt = K / BK;
    unsigned voffA[2], voffB[2];
#pragma unroll
    for (int i = 0; i < 2; ++i) { int R, C; stage_rc(tid * 16 + i * 8192, R, C); const int Rb = Epi::PERM ? ((R & ~31) + perm32(R & 31)) : R;
        voffA[i] = (unsigned)(R * K + C) * 2u; voffB[i] = (unsigned)(Rb * K + C) * 2u; }
    unsigned voffX[2] = {0u, 0u};
    if constexpr (Epi::XPF) { voffX[0] = (unsigned)(((wr * 64 + (lane >> 2)) * 1024 + wc * 32 + 8 * (lane & 3)) * 2); voffX[1] = voffX[0] + 256u; }
    const size_t kstep = (size_t)(BK * 2);
    const size_t hstep = (size_t)HALF * K * 2;
    const size_t tstep = 2 * hstep;
    const unsigned ldsw = (unsigned)wid * 1024u;
    const int aoff = lds_byte(wr * 64 + fr, fq * 8), boff = lds_byte(wc * 32 + fr, fq * 8);
#define PG8_SA(b, h) (((b) * 2 + (h)) * HTB)
#define PG8_SB(b, h) ((4 + (b) * 2 + (h)) * HTB)
#define PG8_STAGE(bufoff, gbase, voff) do { _Pragma("unroll") for (int _i = 0; _i < 2; ++_i) \
        __builtin_amdgcn_global_load_lds((const unsigned*)((const char*)(gbase) + (voff)[_i]), (LAS unsigned*)(lds + (bufoff) + ldsw + _i * 8192), 16, 0, 0); } while (0)
#define PG8_LDA(dst, b, h) do { _Pragma("unroll") for (int m = 0; m < 4; ++m) _Pragma("unroll") for (int k = 0; k < 2; ++k) dst[m][k] = *(const LAS bf16x8*)(lds + PG8_SA(b, h) + aoff + m * 2048 + k * 1024); } while (0)
#define PG8_LDB(dst, b, h) do { _Pragma("unroll") for (int n = 0; n < 2; ++n) _Pragma("unroll") for (int k = 0; k < 2; ++k) dst[n][k] = *(const LAS bf16x8*)(lds + PG8_SB(b, h) + boff + n * 2048 + k * 1024); } while (0)
#define PG8_MMA(ai, bj, At, Bt) do { __builtin_amdgcn_s_setprio(1); _Pragma("unroll") for (int m = 0; m < 4; ++m) _Pragma("unroll") for (int n = 0; n < 2; ++n) _Pragma("unroll") for (int k = 0; k < 2; ++k) \
        acc[ai][bj][m][n] = __builtin_amdgcn_mfma_f32_16x16x32_bf16(Bt[n][k], At[m][k], acc[ai][bj][m][n], 0, 0, 0); __builtin_amdgcn_s_setprio(0); } while (0)
#define PG8_WAIT_V(n) asm volatile("s_waitcnt vmcnt(" #n ")" ::: "memory")
#define PG8_WAIT_L(n) asm volatile("s_waitcnt lgkmcnt(" #n ")" ::: "memory")
#define PG8_BAR __builtin_amdgcn_s_barrier()
#define PG8_SCHED __builtin_amdgcn_sched_barrier(0)
    Unit cur, nxt; int ui = 0;
    if (!S.next(0, cur)) return;
    f32x4 acc[2][2][4][2];
#pragma unroll
    for (int a = 0; a < 2; ++a)
#pragma unroll
        for (int b = 0; b < 2; ++b)
#pragma unroll
            for (int m = 0; m < 4; ++m)
#pragma unroll
                for (int n = 0; n < 2; ++n) acc[a][b][m][n] = (f32x4){0.f, 0.f, 0.f, 0.f};
    bf16x8 At[4][2], B0[2][2], B1[2][2];
    const char* cA = (const char*)g.A + (size_t)cur.pm * tstep; const char* cB = (const char*)g.Bt + (size_t)cur.pn * tstep + (size_t)cur.bsel * hstep;
    size_t chB = cur.nb == 2 ? hstep : 0;
    S.a_ready(cur);
    unsigned vP1[2] = {chB == 0 ? 0u : voffB[0], chB == 0 ? 0u : voffB[1]};
    PG8_STAGE(PG8_SB(0, 0), cB, voffB); PG8_STAGE(PG8_SB(0, 1), cB + chB, vP1); PG8_STAGE(PG8_SA(0, 0), cA, voffA); PG8_STAGE(PG8_SA(0, 1), cA + hstep, voffA);
    if (wr == 1) PG8_BAR;
    PG8_WAIT_V(2); PG8_BAR;
    PG8_STAGE(PG8_SB(1, 0), cB + kstep, voffB); PG8_STAGE(PG8_SA(1, 0), cA + kstep, voffA); PG8_STAGE(PG8_SB(1, 1), cB + chB + kstep, vP1);
    PG8_WAIT_V(6); PG8_BAR;
    for (;;) {
        const bool has_next = S.next(ui + 1, nxt);
        const char* nA = has_next ? (const char*)g.A + (size_t)nxt.pm * tstep : cA; const char* nB = has_next ? (const char*)g.Bt + (size_t)nxt.pn * tstep + (size_t)nxt.bsel * hstep : cB;
        const size_t nhB = has_next ? (nxt.nb == 2 ? hstep : 0) : chB;
        const bool full = cur.nb == 2;
        for (int t = 0; t < nt; t += 2) {
            const bool last = (t == nt - 2);
            const char* a1 = cA + (size_t)(t + 1) * kstep;
            const char* a2 = last ? nA : cA + (size_t)(t + 2) * kstep; const char* b2 = last ? nB : cB + (size_t)(t + 2) * kstep;
            const char* a3 = a2 + kstep; const char* b3 = b2 + kstep;
            const size_t hb = last ? nhB : chB;
            if (last && has_next) S.a_ready(nxt);
            PG8_LDB(B0, 0, 0); if (full) PG8_LDB(B1, 0, 1); PG8_SCHED; PG8_LDA(At, 0, 0); PG8_STAGE(PG8_SA(1, 1), a1 + hstep, voffA);
            PG8_WAIT_V(8); PG8_WAIT_L(0); PG8_BAR; PG8_MMA(0, 0, At, B0); if (full) PG8_MMA(0, 1, At, B1); PG8_BAR; PG8_SCHED;
            const char* s4 = b2; const char* s5 = b2 + hb; const char* s0 = a2; const char* s1 = a2 + hstep; const char* s6 = b3; const char* s7 = b3 + hb; const char* s2 = a3;
            const bool dead = last && !has_next;
            unsigned vB[2] = {dead ? 0u : voffB[0], dead ? 0u : voffB[1]}, vA[2] = {dead ? 0u : voffA[0], dead ? 0u : voffA[1]};
            if constexpr (Epi::XPF) { if (last && !has_next && E.xpf_on()) { const char* xt = E.xtile(cur); constexpr size_t GR = 16 * 1024 * 2;
                s4 = xt; s5 = xt + GR; s0 = xt + 2 * GR; s1 = xt + 3 * GR; s6 = xt + 8 * GR; s7 = xt + 9 * GR; s2 = xt + 10 * GR;
                vB[0] = vA[0] = voffX[0]; vB[1] = vA[1] = voffX[1]; } }
            const unsigned vB1[2] = {hb == 0 ? 0u : vB[0], hb == 0 ? 0u : vB[1]};
            PG8_LDA(At, 0, 1); PG8_STAGE(PG8_SB(0, 0), s4, vB); PG8_STAGE(PG8_SB(0, 1), s5, vB1); PG8_STAGE(PG8_SA(0, 0), s0, vA);
            PG8_WAIT_V(8); PG8_WAIT_L(0); PG8_BAR; PG8_MMA(1, 0, At, B0); if (full) PG8_MMA(1, 1, At, B1); PG8_BAR; PG8_SCHED;
            PG8_LDB(B0, 1, 0); if (full) PG8_LDB(B1, 1, 1); PG8_SCHED; PG8_LDA(At, 1, 0); PG8_STAGE(PG8_SA(0, 1), s1, vA);
            PG8_WAIT_V(8); PG8_WAIT_L(0); PG8_BAR; PG8_MMA(0, 0, At, B0); if (full) PG8_MMA(0, 1, At, B1); PG8_BAR; PG8_SCHED;
            PG8_LDA(At, 1, 1); PG8_STAGE(PG8_SB(1, 0), s6, vB); PG8_STAGE(PG8_SB(1, 1), s7, vB1); PG8_STAGE(PG8_SA(1, 0), s2, vA);
            PG8_WAIT_V(8); PG8_WAIT_L(0); PG8_BAR; PG8_MMA(1, 0, At, B0); if (full) PG8_MMA(1, 1, At, B1); PG8_BAR; PG8_SCHED;
        }
        if (wr == 0) PG8_BAR;
        E(acc, cur, wr, wc, fr, fq); S.done(cur);
        if (!has_next) break;
#pragma unroll
        for (int a = 0; a < 2; ++a)
#pragma unroll
            for (int b = 0; b < 2; ++b)
#pragma unroll
                for (int m = 0; m < 4; ++m)
#pragma unroll
                    for (int n = 0; n < 2; ++n) acc[a][b][m][n] = (f32x4){0.f, 0.f, 0.f, 0.f};
        cur = nxt; cA = nA; cB = nB; chB = nhB; ++ui;
        if (wr == 1) PG8_BAR;
    }
    PG8_WAIT_V(0);
    PG8_BAR;
#undef PG8_SA
#undef PG8_SB
#undef PG8_STAGE
#undef PG8_LDA
#undef PG8_LDB
#undef PG8_MMA
#undef PG8_WAIT_V
#undef PG8_WAIT_L
#undef PG8_BAR
#undef PG8_SCHED
}
}

constexpr int SWN = 5632;
__device__ __forceinline__ float rstd_of(const float* ssq, int row) { return 1.0f / sqrtf(ssq[row] * (1.0f / 1024.0f) + 1e-6f); }
__device__ __forceinline__ int cond_of_row(int row) { return row < NCTX ? 0 : 1 + ((row - NCTX) >> 10); }

typedef const f32x4 (&AccRef)[2][2][4][2];
struct EpiSwiglu {
    static constexpr bool HALF_OK = true; static constexpr bool PERM = true; static constexpr bool XPF = false;
    bf16* H; const float* ssq; const float* sw; LAS unsigned char* lds;
    __device__ __forceinline__ void operator()(AccRef acc, const pg8::Unit& u, int wr, int wc, int fr, int fq) const {
        const int row0 = u.pm * 256 + wr * 64 + fr, h0 = u.pn * 128 + 64 * u.bsel + 16 * wc + 4 * fq;
        float rs[2][4];
#pragma unroll
        for (int ai = 0; ai < 2; ++ai)
#pragma unroll
            for (int m = 0; m < 4; ++m) rs[ai][m] = ssq[row0 + ai * 128 + m * 16];
        const float* swc = sw + (size_t)cond_of_row(u.pm * 256) * SWN + h0;
        f32x4 sa[2], su[2];
#pragma unroll
        for (int bj = 0; bj < 2; ++bj) { sa[bj] = *(const f32x4*)(swc + bj * 64); su[bj] = *(const f32x4*)(swc + DFF + bj * 64); }
        const int lane = fq * 16 + fr, r = lane >> 2, qd = lane & 3;
        LAS unsigned char* sc = lds + 131072 + (wr * 4 + wc) * 1024;
        LAS unsigned char* tw0 = sc + fr * 64 + (((fq >> 1)) ^ ((fr >> 1) & 3)) * 16 + (fq & 1) * 8;
        LAS unsigned char* tw1 = sc + fr * 64 + (((fq >> 1) + 2) ^ ((fr >> 1) & 3)) * 16 + (fq & 1) * 8;
        LAS unsigned char* trp = sc + r * 64 + (qd ^ ((r >> 1) & 3)) * 16;
        bf16* hp = H + (size_t)(u.pm * 256 + wr * 64 + r) * DFF + u.pn * 128 + 64 * u.bsel + 16 * wc + (qd >> 1) * 64 + (qd & 1) * 8;
        const bool st = (qd >> 1) < u.nb;
#define ES_TW(q_) do { const int ai = (q_) >> 2, m = (q_) & 3; const float r1 = 1.0f / sqrtf(rs[ai][m] * (1.0f / 1024.0f) + 1e-6f); \
            _Pragma("unroll") for (int bj = 0; bj < 2; ++bj) { if (bj >= u.nb) continue; const f32x4 a = acc[ai][bj][m][0] * r1 + sa[bj], g = acc[ai][bj][m][1] * r1 + su[bj]; \
                u32x2 w; w.x = pk2(silu_f(a[0]) * g[0], silu_f(a[1]) * g[1]); w.y = pk2(silu_f(a[2]) * g[2], silu_f(a[3]) * g[3]); \
                *(LAS u32x2*)(bj ? tw1 : tw0) = w; } } while (0)
        ES_TW(0);
#pragma unroll
        for (int q = 0; q < 8; ++q) {
            const u32x4 o = *(const LAS u32x4*)trp;
            if (q + 1 < 8) ES_TW(q + 1);
            if (st) *(u32x4*)(hp + (size_t)((q >> 2) * 128 + (q & 3) * 16) * DFF) = o;
        }
#undef ES_TW
    }
};
template <bool NEXT>
struct EpiResid {
    static constexpr bool HALF_OK = false; static constexpr bool PERM = true; static constexpr bool XPF = true;
    bf16* X; const float* gate;
    const float* gnext; const float* scnext; bf16* HS; float* ssqw; LAS unsigned char* lds; int ldsmode; float coef; float addss;
    __device__ __forceinline__ bool xpf_on() const { return ldsmode != 0; }
    __device__ __forceinline__ const char* xtile(const pg8::Unit& u) const { return (const char*)(X + (size_t)u.pm * 256 * D + u.pn * 256); }
    __device__ __forceinline__ void operator()(AccRef acc, const pg8::Unit& u, int wr, int wc, int fr, int fq) const {
        const int cond = cond_of_row(u.pm * 256);
        if (ldsmode) {
            const int lane = fq * 16 + fr, jr = lane >> 2, jp = lane & 3;
            LAS unsigned char* lw = lds + (wr * 4 + wc) * 1024;
            LAS unsigned char* rb = lw + lane * 16;
            LAS unsigned char* tr0 = lw + 3 * 16384 + (jr >> 3) * 8192 + ((jr & 7) * 8 + ((2 * jp) ^ (jr & 7))) * 16;
            LAS unsigned char* tr1 = lw + 3 * 16384 + (jr >> 3) * 8192 + ((jr & 7) * 8 + ((2 * jp + 1) ^ (jr & 7))) * 16;
            LAS unsigned char* tw0 = lw + 3 * 16384 + (fr >> 3) * 8192 + ((fr & 7) * 8 + ((2 * fq) ^ (fr & 7))) * 16;
            LAS unsigned char* tw1 = lw + 3 * 16384 + (fr >> 3) * 8192 + ((fr & 7) * 8 + ((2 * fq + 1) ^ (fr & 7))) * 16;
            const size_t so = (size_t)(u.pm * 256 + wr * 64 + jr) * D + u.pn * 256 + wc * 32 + 8 * jp;
            const int colS = u.pn * 256 + wc * 32 + 8 * jp;
            u32x4 x7[2];
#pragma unroll
            for (int bj = 0; bj < 2; ++bj) x7[bj] = *(const u32x4*)(X + so + (size_t)(128 + 48) * D + bj * 128);
            f32x4 gvS[2][2], gmS[2][2];
#pragma unroll
            for (int bj = 0; bj < 2; ++bj)
#pragma unroll
                for (int n = 0; n < 2; ++n) { gvS[bj][n] = *(const f32x4*)(gate + (size_t)cond * NMOD + colS + bj * 128 + n * 4) * coef;
                    if (NEXT) gmS[bj][n] = *(const f32x4*)(gnext + colS + bj * 128 + n * 4) * (*(const f32x4*)(scnext + (size_t)cond * NMOD + colS + bj * 128 + n * 4) + 1.0f);
                    else gmS[bj][n] = (f32x4){0.f, 0.f, 0.f, 0.f}; }
            f32x4 pv[2][2];
#define ER_XCH(q_, dst_) do { _Pragma("unroll") for (int bj = 0; bj < 2; ++bj) { *(LAS f32x4*)tw0 = acc[(q_) >> 2][bj][(q_) & 3][0]; *(LAS f32x4*)tw1 = acc[(q_) >> 2][bj][(q_) & 3][1]; \
                dst_[bj][0] = *(const LAS f32x4*)tr0; dst_[bj][1] = *(const LAS f32x4*)tr1; } } while (0)
            ER_XCH(0, pv);
#define ER_LGRP(q_, SLOT_, W_) { u32x4 xr[2]; f32x4 pn[2][2]; \
            if ((q_) < 7) { asm volatile("s_waitcnt vmcnt(" #W_ ")" ::: "memory"); \
                _Pragma("unroll") for (int bj = 0; bj < 2; ++bj) xr[bj] = *(const LAS u32x4*)(rb + (SLOT_) * 16384 + bj * 8192); } \
            else { xr[0] = x7[0]; xr[1] = x7[1]; } \
            if ((q_) + 1 < 8) ER_XCH((q_) + 1, pn); \
            const size_t ro = so + (size_t)(((q_) >> 2) * 128 + ((q_) & 3) * 16) * D; float ss = 0.f; \
            _Pragma("unroll") for (int bj = 0; bj < 2; ++bj) { \
                const f32x4 xa = {bflo(xr[bj].x), bfhi(xr[bj].x), bflo(xr[bj].y), bfhi(xr[bj].y)}, xb = {bflo(xr[bj].z), bfhi(xr[bj].z), bflo(xr[bj].w), bfhi(xr[bj].w)}; \
                const f32x4 x0 = xa + pv[bj][0] * gvS[bj][0], x1 = xb + pv[bj][1] * gvS[bj][1]; \
                u32x4 xo; xo.x = pk2(x0[0], x0[1]); xo.y = pk2(x0[2], x0[3]); xo.z = pk2(x1[0], x1[1]); xo.w = pk2(x1[2], x1[3]); *(u32x4*)(X + ro + bj * 128) = xo; \
                if (NEXT) { ss += ((x0[0] * x0[0] + x0[1] * x0[1]) + (x0[2] * x0[2] + x0[3] * x0[3])) + ((x1[0] * x1[0] + x1[1] * x1[1]) + (x1[2] * x1[2] + x1[3] * x1[3])); \
                    const f32x4 h0 = x0 * gmS[bj][0], h1 = x1 * gmS[bj][1]; \
                    u32x4 ho; ho.x = pk2(h0[0], h0[1]); ho.y = pk2(h0[2], h0[3]); ho.z = pk2(h1[0], h1[1]); ho.w = pk2(h1[2], h1[3]); *(u32x4*)(HS + ro + bj * 128) = ho; } } \
            if (NEXT) { ss += __shfl_xor(ss, 1); ss += __shfl_xor(ss, 2); \
                if (jp == 0) atomicAdd(ssqw + u.pm * 256 + wr * 64 + ((q_) >> 2) * 128 + ((q_) & 3) * 16 + jr, ss * addss); } \
            if ((q_) + 1 < 8) { _Pragma("unroll") for (int bj = 0; bj < 2; ++bj) { pv[bj][0] = pn[bj][0]; pv[bj][1] = pn[bj][1]; } } \
            __builtin_amdgcn_sched_barrier(0); }
            if (NEXT) { ER_LGRP(0, 4, 12) ER_LGRP(1, 5, 14) ER_LGRP(2, 0, 16) ER_LGRP(3, 1, 18) ER_LGRP(4, 6, 20) ER_LGRP(5, 7, 22) ER_LGRP(6, 2, 24) ER_LGRP(7, 0, 0) }
            else      { ER_LGRP(0, 4, 12) ER_LGRP(1, 5, 12) ER_LGRP(2, 0, 12) ER_LGRP(3, 1, 12) ER_LGRP(4, 6, 12) ER_LGRP(5, 7, 12) ER_LGRP(6, 2, 12) ER_LGRP(7, 0, 0) }
#undef ER_LGRP
#undef ER_XCH
        } else {
            const int row0 = u.pm * 256 + wr * 64 + fr, col0 = u.pn * 256 + wc * 32 + 8 * fq;
            f32x4 gv[2][2], gm[2][2];
#pragma unroll
            for (int bj = 0; bj < 2; ++bj)
#pragma unroll
                for (int n = 0; n < 2; ++n) { gv[bj][n] = *(const f32x4*)(gate + (size_t)cond * NMOD + col0 + bj * 128 + n * 4) * coef;
                    if (NEXT) gm[bj][n] = *(const f32x4*)(gnext + col0 + bj * 128 + n * 4) * (*(const f32x4*)(scnext + (size_t)cond * NMOD + col0 + bj * 128 + n * 4) + 1.0f);
                    else gm[bj][n] = (f32x4){0.f, 0.f, 0.f, 0.f}; }
#pragma unroll
            for (int q = 0; q < 8; ++q) { const int ai = q >> 2, m = q & 3, row = row0 + ai * 128 + m * 16; float ss = 0.f;
#pragma unroll
                for (int bj = 0; bj < 2; ++bj) { const u32x4 xr = *(const u32x4*)(X + (size_t)row * D + col0 + bj * 128);
                    const f32x4 xa = {bflo(xr.x), bfhi(xr.x), bflo(xr.y), bfhi(xr.y)}, xb = {bflo(xr.z), bfhi(xr.z), bflo(xr.w), bfhi(xr.w)};
                    const f32x4 x0 = xa + acc[ai][bj][m][0] * gv[bj][0], x1 = xb + acc[ai][bj][m][1] * gv[bj][1];
                    u32x4 xo; xo.x = pk2(x0[0], x0[1]); xo.y = pk2(x0[2], x0[3]); xo.z = pk2(x1[0], x1[1]); xo.w = pk2(x1[2], x1[3]); *(u32x4*)(X + (size_t)row * D + col0 + bj * 128) = xo;
                    if (NEXT) { ss += ((x0[0] * x0[0] + x0[1] * x0[1]) + (x0[2] * x0[2] + x0[3] * x0[3])) + ((x1[0] * x1[0] + x1[1] * x1[1]) + (x1[2] * x1[2] + x1[3] * x1[3]));
                        const f32x4 h0 = x0 * gm[bj][0], h1 = x1 * gm[bj][1];
                        u32x4 ho; ho.x = pk2(h0[0], h0[1]); ho.y = pk2(h0[2], h0[3]); ho.z = pk2(h1[0], h1[1]); ho.w = pk2(h1[2], h1[3]); *(u32x4*)(HS + (size_t)row * D + col0 + bj * 128) = ho; } }
                if (NEXT) { ss += __shfl_xor(ss, 16); ss += __shfl_xor(ss, 32); if (fq == 0) atomicAdd(ssqw + row, ss * addss); } }
        }
    }
};
struct EpiF32 {
    static constexpr bool HALF_OK = true; static constexpr bool PERM = false; static constexpr bool XPF = false;
    float* C; int ldc;
    __device__ __forceinline__ void operator()(AccRef acc, const pg8::Unit& u, int wr, int wc, int fr, int fq) const {
        const int row0 = u.pm * 256 + wr * 64 + fr, col0 = u.pn * 256 + 128 * u.bsel + wc * 32 + 4 * fq;
#pragma unroll
        for (int ai = 0; ai < 2; ++ai)
#pragma unroll
            for (int m = 0; m < 4; ++m) { float* rowp = C + (size_t)(row0 + ai * 128 + m * 16) * ldc + col0;
#pragma unroll
                for (int bj = 0; bj < 2; ++bj)
#pragma unroll
                    for (int n = 0; n < 2; ++n) { if (bj < u.nb) *(f32x4*)(rowp + bj * 128 + n * 16) = acc[ai][bj][m][n]; } }
    }
};

struct EpiBf16Plain {
    static constexpr bool HALF_OK = true; static constexpr bool PERM = false; static constexpr bool XPF = false;
    bf16* C; int ldc; const float* ssq; const float* sw;
    __device__ __forceinline__ void operator()(AccRef acc, const pg8::Unit& u, int wr, int wc, int fr, int fq) const {
        const int row0 = u.pm * 256 + wr * 64 + fr, col0 = u.pn * 256 + 128 * u.bsel + wc * 32 + 4 * fq;
        float rs[2][4];
#pragma unroll
        for (int ai = 0; ai < 2; ++ai)
#pragma unroll
            for (int m = 0; m < 4; ++m) rs[ai][m] = ssq[row0 + ai * 128 + m * 16];
        const float* swc = sw + (size_t)cond_of_row(u.pm * 256) * SWN + col0;
        f32x4 sv[2][2];
#pragma unroll
        for (int bj = 0; bj < 2; ++bj)
#pragma unroll
            for (int n = 0; n < 2; ++n) sv[bj][n] = *(const f32x4*)(swc + bj * 128 + n * 16);
#pragma unroll
        for (int ai = 0; ai < 2; ++ai)
#pragma unroll
            for (int m = 0; m < 4; ++m) { bf16* rowp = C + (size_t)(row0 + ai * 128 + m * 16) * ldc + col0; const float r1 = 1.0f / sqrtf(rs[ai][m] * (1.0f / 1024.0f) + 1e-6f);
#pragma unroll
                for (int bj = 0; bj < 2; ++bj)
#pragma unroll
                    for (int n = 0; n < 2; ++n) { if (bj >= u.nb) continue; const f32x4 v = acc[ai][bj][m][n] * r1 + sv[bj][n]; u32x2 o; o.x = pk2(v[0], v[1]); o.y = pk2(v[2], v[3]); *(u32x2*)(rowp + bj * 128 + n * 16) = o; } }
    }
};

#define XB_TMO      128
#define XB_XCNT(j)  (256  + 64 * (j))
#define XB_XSUB(j)  (1280 + 64 * (j))
#define XB_XGEN(j)  (2304 + 64 * (j))
#define XB_TOP      3328
#define XB_TOPGEN   3392
#define XCD_BAR_WORDS 3456
#define XB_SPIN_CAP (1u << 20)
__device__ __forceinline__ unsigned xb_ld(unsigned* p)              { return __hip_atomic_load(p, __ATOMIC_RELAXED, __HIP_MEMORY_SCOPE_AGENT); }
__device__ __forceinline__ unsigned xb_add(unsigned* p, unsigned v) { return __hip_atomic_fetch_add(p, v, __ATOMIC_RELAXED, __HIP_MEMORY_SCOPE_AGENT); }
__device__ __forceinline__ unsigned xb_xcc_id() { return (unsigned)__builtin_amdgcn_s_getreg((3 << 11) | 20) & 0xFu; }
#define XB_SPIN(cond, bar) do { unsigned _sp = 0; while (cond) { __builtin_amdgcn_s_sleep(1); \
    if ((++_sp & 255u) == 0u) { if (xb_ld(&(bar)[XB_TMO])) break; if (_sp > XB_SPIN_CAP) { atomicAdd(&(bar)[XB_TMO], 1u); break; } } } } while (0)
struct XcdBarrier { unsigned* bar; unsigned x; volatile LAS unsigned* st; };
__device__ __forceinline__ XcdBarrier xcd_barrier_post(unsigned* bar, volatile LAS unsigned* st) {
    XcdBarrier b; b.bar = bar; b.x = xb_xcc_id(); b.st = st;
    if (threadIdx.x == 0) (void)xb_add(&bar[XB_XCNT(b.x)], 1u);
    return b;
}
__device__ __forceinline__ void xcd_barrier_complete(unsigned* bar, unsigned x, unsigned& nloc, unsigned& nx) {
    const unsigned G = gridDim.x * gridDim.y * gridDim.z;
    unsigned sum, cnt, mine, sp = 0u;
    for (;;) {
        sum = 0u; cnt = 0u; mine = 0u;
#pragma unroll
        for (unsigned j = 0; j < 16; ++j) { const unsigned c = xb_ld(&bar[XB_XCNT(j)]); sum += c; cnt += (c > 0u) ? 1u : 0u; mine = (j == x) ? c : mine; }
        if (sum == G) break;
        __builtin_amdgcn_s_sleep(1);
        if ((++sp & 255u) == 0u) { if (xb_ld(&bar[XB_TMO])) break; if (sp > XB_SPIN_CAP) { atomicAdd(&bar[XB_TMO], 1u); break; } }
    }
    nloc = mine > 0u ? mine : 1u; nx = cnt > 0u ? cnt : 1u;
}
__device__ __forceinline__ void xcd_barrier(const XcdBarrier& b) {
    asm volatile("s_waitcnt vmcnt(0)" ::: "memory");
    __syncthreads();
    if (threadIdx.x == 0) {
        unsigned* bar = b.bar;
        __builtin_amdgcn_s_waitcnt(0);
        unsigned nloc = b.st[0], nx = b.st[1];
        if (nloc == 0u) { xcd_barrier_complete(bar, b.x, nloc, nx); b.st[0] = nloc; b.st[1] = nx; }
        const unsigned old = xb_add(&bar[XB_XSUB(b.x)], 1u);
        const unsigned gen = old / nloc;
        if (old + 1u == (gen + 1u) * nloc) {
            __builtin_amdgcn_fence(__ATOMIC_RELEASE, "agent");
            asm volatile("s_waitcnt vmcnt(0)" ::: "memory");
            const unsigned og = xb_add(&bar[XB_TOP], 1u);
            const unsigned tg = og / nx;
            if (og + 1u == (tg + 1u) * nx) xb_add(&bar[XB_TOPGEN], 1u);
            else XB_SPIN(xb_ld(&bar[XB_TOPGEN]) == tg, bar);
            __builtin_amdgcn_fence(__ATOMIC_ACQUIRE, "agent");
            xb_add(&bar[XB_XGEN(b.x)], 1u);
            asm volatile("s_waitcnt vmcnt(0)" ::: "memory");
        } else {
            XB_SPIN(xb_ld(&bar[XB_XGEN(b.x)]) == gen, bar);
            __builtin_amdgcn_fence(__ATOMIC_ACQUIRE, "agent");
            asm volatile("s_waitcnt vmcnt(0)" ::: "memory");
        }
    }
    __syncthreads();
}

constexpr size_t MiB = 1u << 20;
constexpr size_t WS_CTL = 0;
constexpr size_t WS_MOD = 1 * MiB;
constexpr size_t WS_ROPE = 2 * MiB;
constexpr size_t WS_CK = 3 * MiB;
constexpr size_t WS_CVT = 4 * MiB;
constexpr size_t WS_SW = 5 * MiB;
constexpr size_t WS_WFI = 6 * MiB;
constexpr size_t WS_WFO = WS_WFI + 8ull * 5632 * 1024 * 2;
constexpr size_t WS_WGI = WS_WFO + 8ull * 1024 * 2816 * 2;
constexpr size_t WS_WGO = WS_WGI + (size_t)GLA_NP * 1024 * 2;
constexpr size_t WS_WNI = WS_WGO + 1024ull * 1024 * 2;
constexpr size_t WS_WNO = WS_WNI + 3072ull * 1024 * 2;
constexpr size_t WS_WMI = WS_WNO + 1024ull * 1024 * 2;
constexpr size_t WS_WMO = WS_WMI + 2048ull * 1024 * 2;
constexpr size_t WS_WSI = WS_WMO + 1024ull * 1024 * 2;
constexpr size_t WS_WSO = WS_WSI + (size_t)SSD_NP * 1024 * 2;
constexpr size_t WS_WEND = WS_WSO + 1024ull * 2048 * 2;
constexpr size_t WS_X = 190 * MiB;
constexpr size_t WS_H = 230 * MiB;
constexpr size_t WS_HID = 250 * MiB;
constexpr size_t WS_R = 306 * MiB;
static_assert(WS_WEND <= WS_X && WS_X + (size_t)M * D * 4 <= WS_H && WS_H + (size_t)M * D * 2 <= WS_HID && WS_HID + (size_t)M * DFF * 2 <= WS_R, "ws map");
constexpr size_t WS_SLAB = 604 * MiB;
constexpr size_t WS_END = 668 * MiB;

constexpr int CW_BAR = 4096, CW_SKTMO = 8192, CW_SK = 16384;
constexpr size_t CTL_ZERO_BYTES = 32768;

constexpr int RING_BYTES = 131072, LDS_BYTES = 147456, LDSCTL_OFF = LDS_BYTES - 512, MISC_OFF = LDSCTL_OFF + 320;
constexpr int NWAVES = 8, NT = 512;

struct Args { const float* in[37]; float* out; unsigned char* ws; int ph_lo, ph_hi; };

struct Frame {
    LAS unsigned char* lds;
    int tid, lane, wave, G, bid;
    const float* const* in; float* out; unsigned char* ws;
};

template <int MAP, bool SWACC>
__device__ __forceinline__ void p0_transpose_item(const float* W, int K, int N, bf16* WT, int row_off, LAS float* scr, int item, int lane, const float* shift, float* sw) {
    const int nblk = N / 32, kb = item / nblk, nb = item % nblk, k0 = 64 * kb, n0 = 32 * nb;
    f32x4 ld[8];
#pragma unroll
    for (int i = 0; i < 8; ++i) ld[i] = __builtin_nontemporal_load((const f32x4*)(W + (size_t)(k0 + 8 * i + (lane >> 3)) * N + n0 + (lane & 7) * 4));
#pragma unroll
    for (int i = 0; i < 8; ++i) { LAS float* d = scr + (8 * i + (lane >> 3)) * 33 + (lane & 7) * 4; d[0] = ld[i][0]; d[1] = ld[i][1]; d[2] = ld[i][2]; d[3] = ld[i][3]; }
    if (SWACC) {
        f32x4 p0 = {0.f, 0.f, 0.f, 0.f}, p1 = p0, p2 = p0;
#pragma unroll
        for (int i = 0; i < 8; ++i) { const int kk = k0 + 8 * i + (lane >> 3); p0 += ld[i] * shift[kk]; p1 += ld[i] * shift[NMOD + kk]; p2 += ld[i] * shift[2 * NMOD + kk]; }
        float r0 = p0[0], r1 = p0[1], r2 = p0[2], r3 = p0[3], r4 = p1[0], r5 = p1[1], r6 = p1[2], r7 = p1[3], r8 = p2[0], r9 = p2[1], r10 = p2[2], r11 = p2[3];
#define RED3(x) x += __shfl_xor(x, 8); x += __shfl_xor(x, 16); x += __shfl_xor(x, 32);
        RED3(r0) RED3(r1) RED3(r2) RED3(r3) RED3(r4) RED3(r5) RED3(r6) RED3(r7) RED3(r8) RED3(r9) RED3(r10) RED3(r11)
#undef RED3
        if ((lane >> 3) == 0) { float* d = sw + n0 + (lane & 7) * 4;
            atomicAdd(d + 0, r0); atomicAdd(d + 1, r1); atomicAdd(d + 2, r2); atomicAdd(d + 3, r3);
            atomicAdd(d + SWN + 0, r4); atomicAdd(d + SWN + 1, r5); atomicAdd(d + SWN + 2, r6); atomicAdd(d + SWN + 3, r7);
            atomicAdd(d + 2 * SWN + 0, r8); atomicAdd(d + 2 * SWN + 1, r9); atomicAdd(d + 2 * SWN + 2, r10); atomicAdd(d + 2 * SWN + 3, r11); }
    }
    asm volatile("s_waitcnt lgkmcnt(0)" ::: "memory");
    const int c = lane & 7;
#pragma unroll
    for (int j = 0; j < 4; ++j) { const int n = (lane >> 3) + 8 * j; const LAS float* s = scr + (8 * c) * 33 + n;
        u32x4 o; o.x = pk2(s[0 * 33], s[1 * 33]); o.y = pk2(s[2 * 33], s[3 * 33]); o.z = pk2(s[4 * 33], s[5 * 33]); o.w = pk2(s[6 * 33], s[7 * 33]);
        int nn = n0 + n, dr;
        if (MAP == 1) { const int which = nn >= DFF ? 1 : 0, jj = nn - which * DFF; dr = 8 * (jj >> 2) + 4 * which + (jj & 3); } else dr = row_off + nn;
        *(u32x4*)(WT + (size_t)dr * K + k0 + 8 * c) = o; }
    asm volatile("s_waitcnt lgkmcnt(0)" ::: "memory");
}

template <int MAP, bool SWACC>
__device__ __forceinline__ void conv_mat(Frame& F, const float* W, int K, int N, bf16* WT, int gw, int NGW, const float* shift, float* sw) {
    LAS float* scr = (LAS float*)(F.lds + 16384 + F.wave * 12288);
    const int nitems = (K / 64) * (N / 32);
    for (int it = gw; it < nitems; it += NGW) p0_transpose_item<MAP, SWACC>(W, K, N, WT, 0, scr, it, F.lane, shift, sw);
}
__device__ __forceinline__ void mod_layers(Frame& F, int l_lo, int l_hi, int widx, int nw);
template <int GRP>
__device__ __forceinline__ void conv_group(Frame& F, int gw, int NGW) {
    const float* const* in = F.in; unsigned char* ws = F.ws;
    const float* MODp = (const float*)(ws + WS_MOD); float* SWp = (float*)(ws + WS_SW);
#define CV_FI(w) conv_mat<1, true>(F, in[11] + (size_t)(w) * 1024 * 5632, 1024, 5632, (bf16*)(ws + WS_WFI) + (size_t)(w) * 5632 * 1024, gw, NGW, MODp + (size_t)((w) / 2) * 3 * NMOD + (size_t)(3 * (((w) % 2) * 2)) * D, SWp + (size_t)(w) * 3 * SWN)
#define CV_FO(w) conv_mat<0, false>(F, in[12] + (size_t)(w) * 2816 * 1024, 2816, 1024, (bf16*)(ws + WS_WFO) + (size_t)(w) * 1024 * 2816, gw, NGW, nullptr, nullptr)
#define CV_MIXIN(idx, NN, dst, l, j) conv_mat<0, true>(F, in[idx], 1024, NN, (bf16*)(ws + dst), gw, NGW, MODp + (size_t)(l) * 3 * NMOD + 3 * D, SWp + (size_t)(j) * 3 * SWN)
#define CV_OUT(idx, KK, dst) conv_mat<0, false>(F, in[idx], KK, 1024, (bf16*)(ws + dst), gw, NGW, nullptr, nullptr)
    if constexpr (GRP == 0) { CV_FI(0); CV_FO(0);
        for (int bh = 0; bh < 32; ++bh) conv_mat<0, false>(F, in[4] + (size_t)bh * 256 * 64, 256, 64, (bf16*)(ws + WS_CVT) + (size_t)bh * 64 * 256, gw, NGW, nullptr, nullptr); }
    if constexpr (GRP == 1) { mod_layers(F, 1, 2, gw / NWAVES, NGW / NWAVES); CV_MIXIN(13, 3072, WS_WGI, 0, 8); CV_OUT(18, 1024, WS_WGO); CV_FI(1); CV_FO(1); }
    if constexpr (GRP == 2) { CV_FI(2); CV_FO(2); }
    if constexpr (GRP == 3) { mod_layers(F, 2, 3, gw / NWAVES, NGW / NWAVES); CV_MIXIN(19, 3072, WS_WNI, 1, 9); CV_OUT(21, 1024, WS_WNO); CV_FI(3); CV_FO(3); }
    if constexpr (GRP == 4) { mod_layers(F, 3, 4, gw / NWAVES, NGW / NWAVES); CV_FI(4); CV_FO(4); CV_MIXIN(22, 2048, WS_WMI, 2, 10); CV_OUT(27, 1024, WS_WMO); }
    if constexpr (GRP == 5) { CV_FI(5); }
    if constexpr (GRP == 6) { CV_FO(5); CV_FI(6); CV_FO(6); }
    if constexpr (GRP == 7) { CV_MIXIN(28, 5184, WS_WSI, 3, 11); CV_OUT(35, 2048, WS_WSO); }
    if constexpr (GRP == 8) { CV_FI(7); }
    if constexpr (GRP == 9) { CV_FO(7); }
#undef CV_FI
#undef CV_FO
#undef CV_MIXIN
#undef CV_OUT
}
__device__ __forceinline__ void mod_layers(Frame& F, int l_lo, int l_hi, int widx, int nw) {
    const float* const* in = F.in;
    LAS float* sc = (LAS float*)F.lds;
    LAS float* red = sc + 3 * 1024;
    __syncthreads();
    for (int i = F.tid; i < 3 * 1024; i += NT) { const int c = i >> 10, k = i & 1023; const float v = c == 0 ? in[7][k] : in[6][(c - 1) * 1024 + k]; sc[i] = v / (1.0f + expf(-v)); }
    __syncthreads();
    float* MOD = (float*)(F.ws + WS_MOD);
    const int kq = F.lane >> 3, c4 = (F.lane & 7) * 4;
    for (int item = l_lo * 288 + widx; item < l_hi * 288; item += nw) { const int l = item / 288, cb = item % 288;
        const float* W = in[9] + (size_t)l * 1024 * NMOD + cb * 32 + c4;
        f32x4 a0 = {0, 0, 0, 0}, a1 = a0, a2 = a0;
        const int kbeg = F.wave * 128 + kq;
        f32x4 w[16];
#pragma unroll
        for (int j = 0; j < 16; ++j) w[j] = __builtin_nontemporal_load((const f32x4*)(W + (size_t)(kbeg + 8 * j) * NMOD));
#pragma unroll
        for (int j = 0; j < 16; ++j) { const int k = kbeg + 8 * j; a0 += w[j] * sc[k]; a1 += w[j] * sc[1024 + k]; a2 += w[j] * sc[2048 + k]; }
#pragma unroll
        for (int e = 0; e < 4; ++e) {
#pragma unroll
            for (int o = 8; o < 64; o <<= 1) { a0[e] += __shfl_xor(a0[e], o); a1[e] += __shfl_xor(a1[e], o); a2[e] += __shfl_xor(a2[e], o); } }
        if (kq == 0) { *(LAS f32x4*)(red + (F.wave * 3 + 0) * 32 + c4) = a0; *(LAS f32x4*)(red + (F.wave * 3 + 1) * 32 + c4) = a1; *(LAS f32x4*)(red + (F.wave * 3 + 2) * 32 + c4) = a2; }
        __syncthreads();
        if (F.tid < 96) { const int c = F.tid >> 5, n = F.tid & 31; float s2 = in[10][l * NMOD + cb * 32 + n];
#pragma unroll
            for (int w8 = 0; w8 < 8; ++w8) s2 += red[(w8 * 3 + c) * 32 + n];
            MOD[(size_t)(l * 3 + c) * NMOD + cb * 32 + n] = s2; }
        __syncthreads();
    }
}
__device__ __forceinline__ void p0_phase(Frame& F) {
    const float* const* in = F.in; unsigned char* ws = F.ws;
    { const f32x4 z = {0.f, 0.f, 0.f, 0.f}; f32x4* swz = (f32x4*)(ws + WS_SW); f32x4* lnz = (f32x4*)(ws + WS_CTL + 640 * 1024);
      for (int i = F.bid * NT + F.tid; i < 12 * 3 * SWN / 4; i += F.G * NT) swz[i] = z;
      for (int i = F.bid * NT + F.tid; i < 32768 / 4; i += F.G * NT) lnz[i] = z; }
    mod_layers(F, 0, 1, F.bid, F.G);
    { float* RC = (float*)(ws + WS_ROPE); float* RS = RC + 65536;
      for (int i = F.bid * NT + F.tid; i < 65536; i += F.G * NT) { const int t = i >> 6, j = i & 63, hs = j >> 5, fi = j & 31;
          const float inv = powf(10000.0f, -(float)(2 * fi) / 64.0f); const float pos = (float)(hs == 0 ? (t >> 6) : (t & 63)); const float ang = pos * inv;
          RC[i] = cosf(ang); RS[i] = sinf(ang); } }
    { bf16* WGI = (bf16*)(ws + WS_WGI);
      for (int i = F.bid * NT + F.tid; i < 256 * 1024; i += F.G * NT) { const int r = i >> 10, d = i & 1023;
          float v = 0.f; if (r < 32) { const int e = r >> 4, rr = r & 15; v = in[14][((size_t)e * 1024 + d) * 16 + rr]; }
          WGI[(size_t)(3072 + r) * 1024 + d] = (bf16)f2bf(v); }
      bf16* WSI = (bf16*)(ws + WS_WSI);
      for (int i = F.bid * NT + F.tid; i < 192 * 1024; i += F.G * NT) WSI[(size_t)5184 * 1024 + i] = 0; }
    { bf16* CK = (bf16*)(ws + WS_CK);
      for (int i = F.bid * NT + F.tid; i < 2 * 16 * 256 * 64 / 4; i += F.G * NT) { const f32x4 v = *(const f32x4*)(in[3] + (size_t)i * 4); u32x2 o; o.x = pk2(v[0], v[1]); o.y = pk2(v[2], v[3]); *(u32x2*)(CK + (size_t)i * 4) = o; } }
}

__device__ __forceinline__ void first_norm_phase(Frame& F, const float* xp, const float* xs, bf16* X, const float* g, const float* mod  , bf16* HS, float* SSQ) {
    const int gw = F.bid * NWAVES + F.wave, NGW = F.G * NWAVES;
    constexpr int RB = 5;
    f32x4 gg[4];
#pragma unroll
    for (int j = 0; j < 4; ++j) gg[j] = *(const f32x4*)(g + 4 * F.lane + 256 * j);
    for (int base = gw; base < M; base += RB * NGW) {
        f32x4 v[RB][4];
#pragma unroll
        for (int k = 0; k < RB; ++k) { const int row = base + k * NGW, rc = row < M ? row : gw;
            const float* xr = rc < NCTX ? xp + (size_t)rc * D : xs + (size_t)(rc - NCTX) * D;
#pragma unroll
            for (int j = 0; j < 4; ++j) v[k][j] = __builtin_nontemporal_load((const f32x4*)(xr + 4 * F.lane + 256 * j)); }
#pragma unroll
        for (int k = 0; k < RB; ++k) { const int row = base + k * NGW; float s = 0.f;
#pragma unroll
            for (int j = 0; j < 4; ++j) s += (v[k][j][0] * v[k][j][0] + v[k][j][1] * v[k][j][1]) + (v[k][j][2] * v[k][j][2] + v[k][j][3] * v[k][j][3]);
            s = wave_sum(s);
            if (row < M) { const float* md = mod + (size_t)cond_of_row(row) * NMOD;
                if (F.lane == 0) SSQ[row] = s;
#pragma unroll
                for (int j = 0; j < 4; ++j) { const int c = 4 * F.lane + 256 * j;
                    { u32x2 xo; xo.x = pk2(v[k][j][0], v[k][j][1]); xo.y = pk2(v[k][j][2], v[k][j][3]); *(u32x2*)(X + (size_t)row * D + c) = xo; }
                    const f32x4 y = v[k][j] * gg[j] * (*(const f32x4*)(md + c) + 1.0f);
                    u32x2 o; o.x = pk2(y[0], y[1]); o.y = pk2(y[2], y[3]); *(u32x2*)(HS + (size_t)row * D + c) = o; } } }
    }
    { const float* const* in = F.in; const float* sh = (const float*)(F.ws + WS_MOD) + 3 * D; float* swg = (float*)(F.ws + WS_SW) + (size_t)8 * 3 * SWN;
      for (int o = gw; o < 96; o += NGW) { const int cond = o >> 5, r = o & 31, e = r >> 4, rr = r & 15; float a = 0.f;
          for (int d = F.lane; d < 1024; d += 64) a += sh[(size_t)cond * NMOD + d] * in[14][((size_t)e * 1024 + d) * 16 + rr];
          a = wave_sum(a); if (F.lane == 0) swg[(size_t)cond * SWN + 3072 + r] = a; } }
    conv_group<0>(F, gw, NGW);
}
__device__ __forceinline__ void final_norm_phase(Frame& F, const bf16* X, const float* g, float* out) {
    const int gw = F.bid * NWAVES + F.wave, NGW = F.G * NWAVES;
    constexpr int RB = 5;
    f32x4 gg[4];
#pragma unroll
    for (int j = 0; j < 4; ++j) gg[j] = *(const f32x4*)(g + 4 * F.lane + 256 * j);
    for (int base = gw; base < M; base += RB * NGW) {
        f32x4 v[RB][4];
#pragma unroll
        for (int k = 0; k < RB; ++k) { const int row = base + k * NGW, rc = row < M ? row : gw;
#pragma unroll
            for (int j = 0; j < 4; ++j) { const u32x2 xr = *(const u32x2*)(X + (size_t)rc * D + 4 * F.lane + 256 * j); v[k][j] = (f32x4){bflo(xr.x), bfhi(xr.x), bflo(xr.y), bfhi(xr.y)}; } }
#pragma unroll
        for (int k = 0; k < RB; ++k) { const int row = base + k * NGW; float s = 0.f;
#pragma unroll
            for (int j = 0; j < 4; ++j) s += (v[k][j][0] * v[k][j][0] + v[k][j][1] * v[k][j][1]) + (v[k][j][2] * v[k][j][2] + v[k][j][3] * v[k][j][3]);
            const float rstd = 1.0f / sqrtf(wave_sum(s) * (1.0f / D) + 1e-6f);
            if (row < M) {
#pragma unroll
                for (int j = 0; j < 4; ++j) __builtin_nontemporal_store(v[k][j] * rstd * gg[j], (f32x4*)(out + (size_t)row * D + 4 * F.lane + 256 * j)); } }
    }
}


__device__ __forceinline__ unsigned pk4lo(const f32x4 v) { return pk2(v[0], v[1]); }
__device__ __forceinline__ unsigned pk4hi(const f32x4 v) { return pk2(v[2], v[3]); }
constexpr size_t GLA_UNIT_BYTES = 16384 * 3 + 512;
__device__ __forceinline__ void gla_prep_phase(Frame& F, const bf16* PROJ, unsigned char* GP, const float* w_a2, const float* b_a, const float* RC, const float* RS) {
    constexpr int S2 = 72;
    LAS float* z1s = (LAS float*)F.lds;
    LAS float* tot4 = z1s + 1024;
    LAS bf16* khT = (LAS bf16*)(tot4 + 512);
    const int tid = F.tid, d = tid & 127, qt = tid >> 7;
    const float qscale = 0.08838834764831845f;
    for (int u = F.bid; u < 160 * 8; u += F.G) { const int dir = u & 1, h = (u >> 1) & 3, ch = u >> 3, row0 = ch * 64;
        float w2[16];
#pragma unroll
        for (int rr = 0; rr < 16; ++rr) w2[rr] = w_a2[(size_t)(dir * 16 + rr) * 512 + h * 128 + d];
        const float bad = b_a[dir * 512 + h * 128 + d];
        float z1v[2];
#pragma unroll
        for (int e = 0; e < 2; ++e) { const int idx = tid + 512 * e; z1v[e] = bf2f(PROJ[(size_t)(row0 + (idx >> 4)) * GLA_NP + 3072 + dir * 16 + (idx & 15)]); }
        float qv[16], kv[16];
#pragma unroll
        for (int e = 0; e < 16; ++e) { const size_t rb = (size_t)(row0 + 16 * qt + e) * GLA_NP; qv[e] = bf2f(PROJ[rb + h * 128 + d]); kv[e] = bf2f(PROJ[rb + 512 + h * 128 + d]); }
        if (row0 >= NCTX) {
            const int hs = d >> 6, dd = d & 63, fi = dd & 31, pd = dd < 32 ? d + 32 : d - 32;
#pragma unroll
            for (int e = 0; e < 16; ++e) { const int row = row0 + 16 * qt + e, t = (row - NCTX) & 1023; const size_t rb = (size_t)row * GLA_NP;
                const float cs = RC[t * 64 + hs * 32 + fi], sn = RS[t * 64 + hs * 32 + fi], q2 = bf2f(PROJ[rb + h * 128 + pd]), k2 = bf2f(PROJ[rb + 512 + h * 128 + pd]);
                if (dd < 32) { qv[e] = qv[e] * cs - q2 * sn; kv[e] = kv[e] * cs - k2 * sn; } else { qv[e] = q2 * sn + qv[e] * cs; kv[e] = k2 * sn + kv[e] * cs; } }
        }
        __syncthreads();
#pragma unroll
        for (int e = 0; e < 2; ++e) z1s[tid + 512 * e] = z1v[e];
        __syncthreads();
        float P[16];
#pragma unroll
        for (int e = 0; e < 16; ++e) { const LAS f32x4* zp = (const LAS f32x4*)(z1s + (16 * qt + e) * 16); float z = bad;
#pragma unroll
            for (int r4 = 0; r4 < 4; ++r4) { const f32x4 x = zp[r4]; z += (x[0] * w2[4 * r4] + x[1] * w2[4 * r4 + 1]) + (x[2] * w2[4 * r4 + 2] + x[3] * w2[4 * r4 + 3]); }
            P[e] = (fminf(z, 0.f) - __logf(1.0f + __expf(-fabsf(z)))) * (1.0f / 16.0f); }
        if (dir == 0) {
#pragma unroll
            for (int e = 1; e < 16; ++e) P[e] += P[e - 1];
        } else {
#pragma unroll
            for (int e = 14; e >= 0; --e) P[e] += P[e + 1];
        }
        tot4[qt * 128 + d] = dir == 0 ? P[15] : P[0];
        __syncthreads();
        const float t0 = tot4[d], t1 = tot4[128 + d], t2 = tot4[256 + d], t3 = tot4[384 + d]; const float total = (t0 + t1) + (t2 + t3);
        float off;
        if (dir == 0) off = qt == 0 ? 0.f : (qt == 1 ? t0 : (qt == 2 ? t0 + t1 : t0 + t1 + t2));
        else off = qt == 3 ? 0.f : (qt == 2 ? t3 : (qt == 1 ? t3 + t2 : t3 + t2 + t1));
        unsigned char* ub = GP + (size_t)u * GLA_UNIT_BYTES;
        bf16* Qo = (bf16*)ub; bf16* Ko = Qo + 8192; bf16* KHo = Ko + 8192; float* GDo = (float*)(ub + 49152);
        if (qt == 0) GDo[d] = __expf(total);
#pragma unroll
        for (int e = 0; e < 16; ++e) { const int i = 16 * qt + e; const float Pe = P[e] + off; const float q = qv[e] * qscale, k = kv[e];
            Qo[i * 128 + d] = (bf16)f2bf(q * __expf(Pe)); Ko[i * 128 + d] = (bf16)f2bf(k * __expf(fminf(-Pe, 80.f))); khT[d * S2 + i] = (bf16)f2bf(k * __expf(total - Pe)); }
        __syncthreads();
#pragma unroll
        for (int e = 0; e < 2; ++e) { const int pc = tid + 512 * e, row = pc >> 3, c8 = (pc & 7) * 8; *(u32x4*)(KHo + row * 64 + c8) = *(const LAS u32x4*)(khT + row * S2 + c8); }
    }
}
template <bool LAT>
__device__ __forceinline__ void gla_unit2(Frame& F, int uid, const bf16* PROJ, const unsigned char* GP, bf16* O, const float* state_in, float* state_out) {
    constexpr int S1 = 136, S2 = 72;
    LAS bf16* qS = (LAS bf16*)F.lds;
    LAS bf16* kS = qS + 64 * S1;
    LAS bf16* khT = kS + 64 * S1;
    LAS bf16* vT = khT + 128 * S2;
    LAS bf16* At = vT + 64 * S2;
    LAS bf16* Sb = At + 64 * S2;
    LAS float* gd = (LAS float*)(Sb + 64 * S1);
    const int tid = F.tid, lane = F.lane, w = F.wave, r = lane & 15, g4 = lane >> 4;
    const int vsl = uid & 3, dir = (uid >> 2) & 1, h = (uid >> 3) & 3, b = uid >> 5;
    constexpr int T = LAT ? 1024 : 256, nch = T / 64;
    const int rowbase = LAT ? NCTX + b * 1024 : b * 256;
    f32x4 S[4];
#pragma unroll
    for (int vt = 0; vt < 4; ++vt)
#pragma unroll
        for (int e = 0; e < 4; ++e) S[vt][e] = LAT ? state_in[((size_t)((b * 2 + dir) * 4 + h) * 128 + 16 * w + 4 * g4 + e) * 256 + vsl * 64 + 16 * vt + r] : 0.f;
    __syncthreads();
#pragma unroll
    for (int vt = 0; vt < 4; ++vt) { u32x2 o; o.x = pk4lo(S[vt]); o.y = pk4hi(S[vt]); *(LAS u32x2*)(Sb + (16 * vt + r) * S1 + 16 * w + 4 * g4) = o; }
    u32x4 pq[2], pk[2], ph[2]; unsigned vreg[4]; float pgd = 0.f;
#define GLA_LOAD(c_) do { const int cc_ = dir == 0 ? (c_) : nch - 1 - (c_); const int tok0_ = cc_ * 64; \
        const unsigned char* ub_ = GP + (size_t)((((rowbase + tok0_) >> 6) * 4 + h) * 2 + dir) * GLA_UNIT_BYTES; \
        _Pragma("unroll") for (int e = 0; e < 2; ++e) { const int pc = tid + 512 * e; pq[e] = *(const u32x4*)(ub_ + (size_t)pc * 16); pk[e] = *(const u32x4*)(ub_ + 16384 + (size_t)pc * 16); ph[e] = *(const u32x4*)(ub_ + 32768 + (size_t)pc * 16); } \
        if (tid < 128) pgd = *(const float*)(ub_ + 49152 + tid * 4); \
        _Pragma("unroll") for (int e = 0; e < 4; ++e) vreg[e] = *(const unsigned*)(PROJ + (size_t)(rowbase + tok0_ + 4 * (tid >> 5) + e) * GLA_NP + 1024 + h * 256 + vsl * 64 + (tid & 31) * 2); } while (0)
    GLA_LOAD(0);
#define GLA_STAGE() do { \
        _Pragma("unroll") for (int e = 0; e < 2; ++e) { const int pc = tid + 512 * e; { const int row = pc >> 4, c8 = (pc & 15) * 8; *(LAS u32x4*)(qS + row * S1 + c8) = pq[e]; *(LAS u32x4*)(kS + row * S1 + c8) = pk[e]; } \
            { const int row = pc >> 3, c8 = (pc & 7) * 8; *(LAS u32x4*)(khT + row * S2 + c8) = ph[e]; } } \
        if (tid < 128) gd[tid] = pgd; \
        { const int vp = (tid & 31) * 2, i0 = 4 * (tid >> 5); u32x2 lo, hi;      \
          lo.x = (vreg[0] & 0xffffu) | (vreg[1] << 16); lo.y = (vreg[2] & 0xffffu) | (vreg[3] << 16); hi.x = (vreg[0] >> 16) | (vreg[1] & 0xffff0000u); hi.y = (vreg[2] >> 16) | (vreg[3] & 0xffff0000u); \
          *(LAS u32x2*)(vT + vp * S2 + i0) = lo; *(LAS u32x2*)(vT + (vp + 1) * S2 + i0) = hi; } } while (0)
    GLA_STAGE();
    if (1 < nch) GLA_LOAD(1);
    for (int c = 0; c < nch; ++c) {
        const int cc = dir == 0 ? c : nch - 1 - c, tok0 = cc * 64;
        __syncthreads();
        { const int ti = w >> 1, i = 16 * ti + r;
#pragma unroll
          for (int jj = 0; jj < 2; ++jj) { const int tj = 2 * (w & 1) + jj; f32x4 a = {0.f, 0.f, 0.f, 0.f};
#pragma unroll
              for (int k4 = 0; k4 < 4; ++k4) { const bf16x8 af = *(const LAS bf16x8*)(kS + (16 * tj + r) * S1 + 32 * k4 + 8 * g4), bf = *(const LAS bf16x8*)(qS + i * S1 + 32 * k4 + 8 * g4);
                  a = __builtin_amdgcn_mfma_f32_16x16x32_bf16(af, bf, a, 0, 0, 0); }
#pragma unroll
              for (int e = 0; e < 4; ++e) { const int j = 16 * tj + 4 * g4 + e; const bool ok = dir == 0 ? (j <= i) : (j >= i); a[e] = ok ? a[e] : 0.f; }
              u32x2 o; o.x = pk4lo(a); o.y = pk4hi(a); *(LAS u32x2*)(At + i * S2 + 16 * tj + 4 * g4) = o; } }
        __syncthreads();
        { const int ti = w >> 1, i = 16 * ti + r;
#pragma unroll
          for (int jj = 0; jj < 2; ++jj) { const int vt = 2 * (w & 1) + jj; f32x4 a = {0.f, 0.f, 0.f, 0.f};
#pragma unroll
              for (int k2 = 0; k2 < 2; ++k2) { const bf16x8 af = *(const LAS bf16x8*)(vT + (16 * vt + r) * S2 + 32 * k2 + 8 * g4), bf = *(const LAS bf16x8*)(At + i * S2 + 32 * k2 + 8 * g4);
                  a = __builtin_amdgcn_mfma_f32_16x16x32_bf16(af, bf, a, 0, 0, 0); }
#pragma unroll
              for (int k4 = 0; k4 < 4; ++k4) { const bf16x8 af = *(const LAS bf16x8*)(Sb + (16 * vt + r) * S1 + 32 * k4 + 8 * g4), bf = *(const LAS bf16x8*)(qS + i * S1 + 32 * k4 + 8 * g4);
                  a = __builtin_amdgcn_mfma_f32_16x16x32_bf16(af, bf, a, 0, 0, 0); }
              { u32x2 o; o.x = pk4lo(a); o.y = pk4hi(a); *(u32x2*)(O + ((size_t)dir * M + rowbase + tok0 + i) * D + h * 256 + vsl * 64 + 16 * vt + 4 * g4) = o; } } }
        { const f32x4 gv = *(const LAS f32x4*)(gd + 16 * w + 4 * g4);
#pragma unroll
          for (int vt = 0; vt < 4; ++vt) { f32x4 a = {0.f, 0.f, 0.f, 0.f};
#pragma unroll
              for (int k2 = 0; k2 < 2; ++k2) { const bf16x8 af = *(const LAS bf16x8*)(khT + (16 * w + r) * S2 + 32 * k2 + 8 * g4), bf = *(const LAS bf16x8*)(vT + (16 * vt + r) * S2 + 32 * k2 + 8 * g4);
                  a = __builtin_amdgcn_mfma_f32_16x16x32_bf16(af, bf, a, 0, 0, 0); }
              S[vt] = S[vt] * gv + a; } }
        __syncthreads();
#pragma unroll
        for (int vt = 0; vt < 4; ++vt) { u32x2 o; o.x = pk4lo(S[vt]); o.y = pk4hi(S[vt]); *(LAS u32x2*)(Sb + (16 * vt + r) * S1 + 16 * w + 4 * g4) = o; }
        if (c + 1 < nch) { GLA_STAGE(); if (c + 2 < nch) GLA_LOAD(c + 2); }
    }
#undef GLA_STAGE
#undef GLA_LOAD
    if (!LAT) {
#pragma unroll
        for (int vt = 0; vt < 4; ++vt)
#pragma unroll
            for (int e = 0; e < 4; ++e) __builtin_nontemporal_store(S[vt][e], &state_out[((size_t)((b * 2 + dir) * 4 + h) * 128 + 16 * w + 4 * g4 + e) * 256 + vsl * 64 + 16 * vt + r]);
    }
}
__device__ __forceinline__ void gla_core_phase(Frame& F, const bf16* PROJ, const unsigned char* GP, bf16* O, const float* state_in, float* state_out) {
    if (F.G == 256) {
        if (F.bid < 64) { gla_unit2<true>(F, F.bid, PROJ, GP, O, state_in, state_out); gla_unit2<false>(F, F.bid, PROJ, GP, O, state_in, state_out); }
        else { for (int j = 0; j < 5; ++j) gla_unit2<false>(F, 64 + (F.bid - 64) * 5 + j, PROJ, GP, O, state_in, state_out); }
    } else {
        for (int u = F.bid; u < 64 + 1024; u += F.G) { if (u < 64) gla_unit2<true>(F, u, PROJ, GP, O, state_in, state_out); else gla_unit2<false>(F, u - 64, PROJ, GP, O, state_in, state_out); }
    }
}
__device__ __forceinline__ void gla_combine_phase(Frame& F, const bf16* PROJ, const bf16* O, const float* gn, bf16* Gout) {
    const int gw = F.bid * NWAVES + F.wave, NGW = F.G * NWAVES;
    constexpr int RB = 5;
    f32x4 gg[4];
#pragma unroll
    for (int j = 0; j < 4; ++j) gg[j] = *(const f32x4*)(gn + 256 * j + 4 * F.lane);
    for (int base = gw; base < M; base += RB * NGW) {
        u32x2 of[RB][4], ob[RB][4], rr[RB][4];
#pragma unroll
        for (int k = 0; k < RB; ++k) { const int row = base + k * NGW, rc = row < M ? row : gw;
#pragma unroll
            for (int j = 0; j < 4; ++j) { const int c = 256 * j + 4 * F.lane; of[k][j] = *(const u32x2*)(O + (size_t)rc * D + c); ob[k][j] = *(const u32x2*)(O + ((size_t)M + rc) * D + c); rr[k][j] = *(const u32x2*)(PROJ + (size_t)rc * GLA_NP + 2048 + c); } }
#pragma unroll
        for (int k = 0; k < RB; ++k) { const int row = base + k * NGW;
#pragma unroll
            for (int j = 0; j < 4; ++j) { const int c = 256 * j + 4 * F.lane;
                const f32x4 o = {bflo(of[k][j].x) + bflo(ob[k][j].x), bfhi(of[k][j].x) + bfhi(ob[k][j].x), bflo(of[k][j].y) + bflo(ob[k][j].y), bfhi(of[k][j].y) + bfhi(ob[k][j].y)};
                const float ss = wave_sum((o[0] * o[0] + o[1] * o[1]) + (o[2] * o[2] + o[3] * o[3]));
                const float rstd = 1.0f / sqrtf(ss * (1.0f / 256.0f) + 1e-6f);
                const f32x4 r = {bflo(rr[k][j].x), bfhi(rr[k][j].x), bflo(rr[k][j].y), bfhi(rr[k][j].y)};
                f32x4 y = o * rstd * gg[j]; y[0] *= silu_f(r[0]); y[1] *= silu_f(r[1]); y[2] *= silu_f(r[2]); y[3] *= silu_f(r[3]);
                if (row < M) { u32x2 p; p.x = pk2(y[0], y[1]); p.y = pk2(y[2], y[3]); *(u32x2*)(Gout + (size_t)row * D + c) = p; } } }
    }
}

struct EpiNatQKV {
    static constexpr bool HALF_OK = true; static constexpr bool PERM = false; static constexpr bool XPF = false;
    bf16* Q; bf16* K; bf16* VTC; bf16* VTL; float* outK; float* outV; const float* ssq; const float* sw;
    __device__ __forceinline__ void operator()(AccRef acc, const pg8::Unit& u, int wr, int wc, int fr, int fq) const {
        const int part = u.pn >> 2, colbase = (u.pn & 3) * 256 + 128 * u.bsel + wc * 32 + 4 * fq, row0 = u.pm * 256 + wr * 64 + fr;
        const bool ctx = u.pm < 32;
        float rs[2][4];
#pragma unroll
        for (int ai = 0; ai < 2; ++ai)
#pragma unroll
            for (int m = 0; m < 4; ++m) rs[ai][m] = ssq[row0 + ai * 128 + m * 16];
        const float* swc = sw + (size_t)cond_of_row(u.pm * 256) * SWN + u.pn * 256 + 128 * u.bsel + wc * 32 + 4 * fq;
        f32x4 sv[2][2];
#pragma unroll
        for (int bj = 0; bj < 2; ++bj)
#pragma unroll
            for (int n = 0; n < 2; ++n) sv[bj][n] = *(const f32x4*)(swc + bj * 128 + n * 16);
#pragma unroll
        for (int ai = 0; ai < 2; ++ai)
#pragma unroll
            for (int m = 0; m < 4; ++m) { const int row = row0 + ai * 128 + m * 16; const float r1 = 1.0f / sqrtf(rs[ai][m] * (1.0f / 1024.0f) + 1e-6f);
#pragma unroll
                for (int bj = 0; bj < 2; ++bj)
#pragma unroll
                    for (int n = 0; n < 2; ++n) { if (bj >= u.nb) continue; const int c = colbase + bj * 128 + n * 16; const f32x4 v = acc[ai][bj][m][n] * r1 + sv[bj][n]; const int hh = c >> 6, d = c & 63;
                        if (part == 0) { u32x2 p; p.x = pk2(v[0] * 0.125f, v[1] * 0.125f); p.y = pk2(v[2] * 0.125f, v[3] * 0.125f); *(u32x2*)(Q + (size_t)row * D + c) = p; }
                        else if (part == 1) { u32x2 p; p.x = pk2(v[0], v[1]); p.y = pk2(v[2], v[3]); *(u32x2*)(K + (size_t)row * D + c) = p;
                            if (ctx) { const int b = row >> 8, sq = row & 255; __builtin_nontemporal_store(v, (f32x4*)(outK + ((size_t)(b * 16 + hh) * 256 + sq) * 64 + d)); } }
                        else { if (ctx) { const int b = row >> 8, sq = row & 255; __builtin_nontemporal_store(v, (f32x4*)(outV + ((size_t)(b * 16 + hh) * 256 + sq) * 64 + d));
#pragma unroll
                                for (int e = 0; e < 4; ++e) VTC[((size_t)(b * 16 + hh) * 64 + d + e) * 256 + sq] = (bf16)f2bf(v[e]); }
                            else { const int bl = (row - NCTX) >> 10, t = (row - NCTX) & 1023;
#pragma unroll
                                for (int e = 0; e < 4; ++e) VTL[((size_t)(bl * 16 + hh) * 64 + d + e) * 1024 + t] = (bf16)f2bf(v[e]); } } } }
    }
};
struct KVGroup { const bf16* k; int kstep, kst; const bf16* v; int vstep, vst; };
struct NatState { float m, l; f32x4 o[4]; };
template <bool BIAS>
__device__ __forceinline__ void nat_group(int r, int g, const bf16x8 (&qf)[2], const KVGroup G, NatState& st, const LAS float* rpb_h, int qrow, int rbase, int cbase, int n16) {
    constexpr int NS = 8;
    f32x4 sc[NS][2];
    bf16x8 kf[2][2][2];
#define NAT_LOADK(s_, buf_) do { _Pragma("unroll") for (int t = 0; t < 2; ++t) { const bf16* kr = G.k + (size_t)(s_) * G.kstep + (size_t)(16 * t + r) * G.kst + 8 * g; kf[buf_][t][0] = *(const bf16x8*)kr; kf[buf_][t][1] = *(const bf16x8*)(kr + 32); } } while (0)
    NAT_LOADK(0, 0);
#pragma unroll
    for (int s = 0; s < NS; ++s) {
        if (s + 1 < NS) NAT_LOADK(s + 1, (s + 1) & 1);
#pragma unroll
        for (int t = 0; t < 2; ++t) { f32x4 a = {0.f, 0.f, 0.f, 0.f};
            a = __builtin_amdgcn_mfma_f32_16x16x32_bf16(kf[s & 1][t][0], qf[0], a, 0, 0, 0);
            a = __builtin_amdgcn_mfma_f32_16x16x32_bf16(kf[s & 1][t][1], qf[1], a, 0, 0, 0);
            sc[s][t] = a; }
        __builtin_amdgcn_sched_barrier(0);
    }
#undef NAT_LOADK
    if (BIAS) {
        const int qcol = n16 + r; int cstart = qcol - 8; cstart = cstart < 0 ? 0 : (cstart > 48 ? 48 : cstart);
#pragma unroll
        for (int s = 0; s < NS; ++s) { const int dri = rbase + s - qrow + 7;
#pragma unroll
            for (int t = 0; t < 2; ++t)
#pragma unroll
                for (int e = 0; e < 4; ++e) { const int kc = cbase + 16 * t + 4 * g + e; int dci = kc - qcol + 15; dci = dci < 0 ? 0 : (dci > 30 ? 30 : dci);
                    const bool ok = kc >= cstart && kc < cstart + 16;
                    const float bias = rpb_h[dri * 31 + dci];
                    sc[s][t][e] = ok ? sc[s][t][e] + bias : -1e30f; } }
    }
    float mx = st.m;
#pragma unroll
    for (int s = 0; s < NS; ++s)
#pragma unroll
        for (int t = 0; t < 2; ++t) mx = fmaxf(mx, fmaxf(fmaxf(sc[s][t][0], sc[s][t][1]), fmaxf(sc[s][t][2], sc[s][t][3])));
    mx = fmaxf(mx, __shfl_xor(mx, 16)); mx = fmaxf(mx, __shfl_xor(mx, 32));
    const float alpha = __expf(st.m - mx);
    st.m = mx; st.l *= alpha;
#pragma unroll
    for (int dt = 0; dt < 4; ++dt) st.o[dt] = st.o[dt] * alpha;
    u32x2 vf[2][4][2];
#define NAT_LOADV(s_, buf_) do { _Pragma("unroll") for (int dt = 0; dt < 4; ++dt) { const bf16* vr = G.v + (size_t)(s_) * G.vstep + (size_t)(16 * dt + r) * G.vst + 4 * g; \
        vf[buf_][dt][0] = *(const u32x2*)vr; vf[buf_][dt][1] = *(const u32x2*)(vr + 16); } } while (0)
    NAT_LOADV(0, 0);
#pragma unroll
    for (int s = 0; s < NS; ++s) {
        if (s + 1 < NS) NAT_LOADV(s + 1, (s + 1) & 1);
        unsigned pw[4];
#pragma unroll
        for (int t = 0; t < 2; ++t) { const float p0 = __expf(sc[s][t][0] - mx), p1 = __expf(sc[s][t][1] - mx), p2 = __expf(sc[s][t][2] - mx), p3 = __expf(sc[s][t][3] - mx);
            pw[2 * t] = pk2(p0, p1); pw[2 * t + 1] = pk2(p2, p3);
            st.l += (bflo(pw[2 * t]) + bfhi(pw[2 * t])) + (bflo(pw[2 * t + 1]) + bfhi(pw[2 * t + 1])); }
        const u32x4 pu = {pw[0], pw[1], pw[2], pw[3]};
        const bf16x8 pf = __builtin_bit_cast(bf16x8, pu);
#pragma unroll
        for (int dt = 0; dt < 4; ++dt) { const u32x4 vu = {vf[s & 1][dt][0].x, vf[s & 1][dt][0].y, vf[s & 1][dt][1].x, vf[s & 1][dt][1].y};
            st.o[dt] = __builtin_amdgcn_mfma_f32_16x16x32_bf16(__builtin_bit_cast(bf16x8, vu), pf, st.o[dt], 0, 0, 0); }
        __builtin_amdgcn_sched_barrier(0);
    }
#undef NAT_LOADV
}
template <bool LAT>
__device__ __forceinline__ void nat_wave_unit(int lane, const bf16* qp  , const KVGroup g0, const KVGroup g1,
                                              bf16* op, const LAS float* rpb_h, int qrow, int rbase, int cbase, int n16) {
    const int r = lane & 15, g = lane >> 4;
    bf16x8 qf[2];
#pragma unroll
    for (int k2 = 0; k2 < 2; ++k2) qf[k2] = *(const bf16x8*)(qp + (size_t)r * D + 32 * k2 + 8 * g);
    NatState st; st.m = -3e38f; st.l = 0.f;
#pragma unroll
    for (int dt = 0; dt < 4; ++dt) st.o[dt] = (f32x4){0.f, 0.f, 0.f, 0.f};
    nat_group<LAT>(r, g, qf, g0, st, rpb_h, qrow, rbase, cbase, n16);
    if (LAT) nat_group<false>(r, g, qf, g1, st, rpb_h, qrow, rbase, cbase, n16);
    float lsum = st.l;
    lsum += __shfl_xor(lsum, 16); lsum += __shfl_xor(lsum, 32);
    const float inv = 1.0f / lsum;
#pragma unroll
    for (int dt = 0; dt < 4; ++dt) { u32x2 o; o.x = pk2(st.o[dt][0] * inv, st.o[dt][1] * inv); o.y = pk2(st.o[dt][2] * inv, st.o[dt][3] * inv);
        *(u32x2*)(op + (size_t)r * D + 16 * dt + 4 * g) = o; }
}
__device__ __forceinline__ void nat_ctx_unit_lds(int lane, const bf16x8 (&qf)[2], const LAS bf16* Ks  , const LAS bf16* Vs  , bf16* op) {
    constexpr int NS = 8, KS = 72, VS = 264;
    const int r = lane & 15, g = lane >> 4;
    f32x4 sc[NS][2];
#pragma unroll
    for (int s = 0; s < NS; ++s)
#pragma unroll
        for (int t = 0; t < 2; ++t) { const LAS bf16* kr = Ks + (32 * s + 16 * t + r) * KS + 8 * g;
            const bf16x8 k0 = *(const LAS bf16x8*)kr, k1 = *(const LAS bf16x8*)(kr + 32);
            f32x4 a = {0.f, 0.f, 0.f, 0.f};
            a = __builtin_amdgcn_mfma_f32_16x16x32_bf16(k0, qf[0], a, 0, 0, 0);
            a = __builtin_amdgcn_mfma_f32_16x16x32_bf16(k1, qf[1], a, 0, 0, 0);
            sc[s][t] = a; __builtin_amdgcn_sched_barrier(0); }
    float mx = -3e38f;
#pragma unroll
    for (int s = 0; s < NS; ++s)
#pragma unroll
        for (int t = 0; t < 2; ++t) mx = fmaxf(mx, fmaxf(fmaxf(sc[s][t][0], sc[s][t][1]), fmaxf(sc[s][t][2], sc[s][t][3])));
    mx = fmaxf(mx, __shfl_xor(mx, 16)); mx = fmaxf(mx, __shfl_xor(mx, 32));
    float lsum = 0.f; f32x4 oacc[4];
#pragma unroll
    for (int dt = 0; dt < 4; ++dt) oacc[dt] = (f32x4){0.f, 0.f, 0.f, 0.f};
#pragma unroll
    for (int s = 0; s < NS; ++s) {
        unsigned pw[4];
#pragma unroll
        for (int t = 0; t < 2; ++t) { const float p0 = __expf(sc[s][t][0] - mx), p1 = __expf(sc[s][t][1] - mx), p2 = __expf(sc[s][t][2] - mx), p3 = __expf(sc[s][t][3] - mx);
            pw[2 * t] = pk2(p0, p1); pw[2 * t + 1] = pk2(p2, p3);
            lsum += (bflo(pw[2 * t]) + bfhi(pw[2 * t])) + (bflo(pw[2 * t + 1]) + bfhi(pw[2 * t + 1])); }
        const u32x4 pu = {pw[0], pw[1], pw[2], pw[3]};
        const bf16x8 pf = __builtin_bit_cast(bf16x8, pu);
#pragma unroll
        for (int dt = 0; dt < 4; ++dt) { const LAS bf16* vr = Vs + (16 * dt + r) * VS + 32 * s + 4 * g;
            const u32x2 v0 = *(const LAS u32x2*)vr, v1 = *(const LAS u32x2*)(vr + 16);
            const u32x4 vu = {v0.x, v0.y, v1.x, v1.y};
            oacc[dt] = __builtin_amdgcn_mfma_f32_16x16x32_bf16(__builtin_bit_cast(bf16x8, vu), pf, oacc[dt], 0, 0, 0); }
        __builtin_amdgcn_sched_barrier(0);
    }
    lsum += __shfl_xor(lsum, 16); lsum += __shfl_xor(lsum, 32);
    const float inv = 1.0f / lsum;
#pragma unroll
    for (int dt = 0; dt < 4; ++dt) { u32x2 o; o.x = pk2(oacc[dt][0] * inv, oacc[dt][1] * inv); o.y = pk2(oacc[dt][2] * inv, oacc[dt][3] * inv);
        *(u32x2*)(op + (size_t)r * D + 16 * dt + 4 * g) = o; }
}
template <bool BIAS>
__device__ __forceinline__ void nat_scores_lds(int r, int g, const bf16x8 (&qf)[2], const LAS bf16* Kl  , int kstep  , f32x4 (&sc)[8][2], NatState& st,
                                               const LAS float* rpb_h, int qrow, int rbase, int cbase, int n16) {
    constexpr int NS = 8;
#pragma unroll
    for (int s = 0; s < NS; ++s)
#pragma unroll
        for (int t = 0; t < 2; ++t) { const LAS bf16* kr = Kl + s * kstep + (16 * t + r) * 72 + 8 * g;
            const bf16x8 k0 = *(const LAS bf16x8*)kr, k1 = *(const LAS bf16x8*)(kr + 32);
            f32x4 a = {0.f, 0.f, 0.f, 0.f};
            a = __builtin_amdgcn_mfma_f32_16x16x32_bf16(k0, qf[0], a, 0, 0, 0);
            a = __builtin_amdgcn_mfma_f32_16x16x32_bf16(k1, qf[1], a, 0, 0, 0);
            sc[s][t] = a; __builtin_amdgcn_sched_barrier(0); }
    if (BIAS) {
        const int qcol = n16 + r; int cstart = qcol - 8; cstart = cstart < 0 ? 0 : (cstart > 48 ? 48 : cstart);
#pragma unroll
        for (int s = 0; s < NS; ++s) { const int dri = rbase + s - qrow + 7;
#pragma unroll
            for (int t = 0; t < 2; ++t)
#pragma unroll
                for (int e = 0; e < 4; ++e) { const int kc = cbase + 16 * t + 4 * g + e; int dci = kc - qcol + 15; dci = dci < 0 ? 0 : (dci > 30 ? 30 : dci);
                    const bool ok = kc >= cstart && kc < cstart + 16;
                    const float bias = rpb_h[dri * 31 + dci];
                    sc[s][t][e] = ok ? sc[s][t][e] + bias : -1e30f; } }
    }
    float mx = st.m;
#pragma unroll
    for (int s = 0; s < NS; ++s)
#pragma unroll
        for (int t = 0; t < 2; ++t) mx = fmaxf(mx, fmaxf(fmaxf(sc[s][t][0], sc[s][t][1]), fmaxf(sc[s][t][2], sc[s][t][3])));
    mx = fmaxf(mx, __shfl_xor(mx, 16)); mx = fmaxf(mx, __shfl_xor(mx, 32));
    const float alpha = __expf(st.m - mx);
    st.m = mx; st.l *= alpha;
#pragma unroll
    for (int dt = 0; dt < 4; ++dt) st.o[dt] = st.o[dt] * alpha;
}
__device__ __forceinline__ void nat_pv_lds(int r, int g, const LAS bf16* Vl  , int vstep, int vstride, const f32x4 (&sc)[8][2], NatState& st) {
    constexpr int NS = 8;
    const float mx = st.m;
#pragma unroll
    for (int s = 0; s < NS; ++s) {
        unsigned pw[4];
#pragma unroll
        for (int t = 0; t < 2; ++t) { const float p0 = __expf(sc[s][t][0] - mx), p1 = __expf(sc[s][t][1] - mx), p2 = __expf(sc[s][t][2] - mx), p3 = __expf(sc[s][t][3] - mx);
            pw[2 * t] = pk2(p0, p1); pw[2 * t + 1] = pk2(p2, p3);
            st.l += (bflo(pw[2 * t]) + bfhi(pw[2 * t])) + (bflo(pw[2 * t + 1]) + bfhi(pw[2 * t + 1])); }
        const u32x4 pu = {pw[0], pw[1], pw[2], pw[3]};
        const bf16x8 pf = __builtin_bit_cast(bf16x8, pu);
#pragma unroll
        for (int dt = 0; dt < 4; ++dt) { const LAS bf16* vr = Vl + (16 * dt + r) * vstride + s * vstep + 4 * g;
            const u32x2 v0 = *(const LAS u32x2*)vr, v1 = *(const LAS u32x2*)(vr + 16);
            const u32x4 vu = {v0.x, v0.y, v1.x, v1.y};
            st.o[dt] = __builtin_amdgcn_mfma_f32_16x16x32_bf16(__builtin_bit_cast(bf16x8, vu), pf, st.o[dt], 0, 0, 0); }
        __builtin_amdgcn_sched_barrier(0);
    }
}
__device__ __forceinline__ void nat_attn_phase(Frame& F, const bf16* Q, const bf16* K, const bf16* VTC, const bf16* VTL, const bf16* CK, const bf16* CVT, const float* rpb, bf16* ATT) {
    { LAS bf16* Ks = (LAS bf16*)F.lds; LAS bf16* Vs = Ks + 256 * 72;
      u32x4 pk[4], pv[4];
#define NAT_CTX_LOAD(bh_) do { const int b_ = (bh_) >> 4, h_ = (bh_) & 15; \
        _Pragma("unroll") for (int e = 0; e < 4; ++e) { const int pc = F.tid + 512 * e; pk[e] = *(const u32x4*)(K + (size_t)(b_ * 256 + (pc >> 3)) * D + h_ * 64 + (pc & 7) * 8); \
            pv[e] = *(const u32x4*)(VTC + (size_t)((bh_) * 64 + (pc >> 5)) * 256 + (pc & 31) * 8); } } while (0)
      if (F.bid < 512) NAT_CTX_LOAD(F.bid);
      for (int bh = F.bid; bh < 512; bh += F.G) { const int b = bh >> 4, h = bh & 15, r = F.lane & 15, g = F.lane >> 4;
        bf16x8 qf[2][2];
#pragma unroll
        for (int i = 0; i < 2; ++i)
#pragma unroll
            for (int k2 = 0; k2 < 2; ++k2) qf[i][k2] = *(const bf16x8*)(Q + (size_t)(b * 256 + (F.wave + 8 * i) * 16 + r) * D + h * 64 + 32 * k2 + 8 * g);
        __syncthreads();
#pragma unroll
        for (int e = 0; e < 4; ++e) { const int pc = F.tid + 512 * e; *(LAS u32x4*)(Ks + (pc >> 3) * 72 + (pc & 7) * 8) = pk[e]; *(LAS u32x4*)(Vs + (pc >> 5) * 264 + (pc & 31) * 8) = pv[e]; }
        if (bh + F.G < 512) NAT_CTX_LOAD(bh + F.G);
        __syncthreads();
#pragma unroll
        for (int i = 0; i < 2; ++i) { const int row0 = b * 256 + (F.wave + 8 * i) * 16;
            nat_ctx_unit_lds(F.lane, qf[i], Ks, Vs, ATT + (size_t)row0 * D + h * 64); }
      }
#undef NAT_CTX_LOAD
    }
    LAS bf16* R = (LAS bf16*)F.lds; LAS float* rpbs = (LAS float*)(F.lds + 84992);
    for (int wu = F.bid; wu < 256; wu += F.G) { const int rp = wu & 7, h = (wu >> 3) & 15, bl = wu >> 7, n = F.wave & 3, rq = 2 * rp + (F.wave >> 2);
        const int tid = F.tid, r = F.lane & 15, g = F.lane >> 4;
        int rb0 = 2 * rp - 4; rb0 = rb0 < 0 ? 0 : (rb0 > 8 ? 8 : rb0); const int wstart = rb0 > 7 ? 7 : rb0;
        int rbase = rq - 4; rbase = rbase < 0 ? 0 : (rbase > 8 ? 8 : rbase);
        int cbase = 16 * n - 8; cbase = cbase < 0 ? 0 : (cbase > 32 ? 32 : cbase);
        const bf16* kwin = K + (size_t)(NCTX + bl * 1024 + wstart * 64) * D + h * 64;
        const bf16* vwin = VTL + (size_t)((bl * 16 + h) * 64) * 1024 + wstart * 64;
        const int row0 = NCTX + bl * 1024 + rq * 64 + 16 * n;
        const bf16* qp = Q + (size_t)row0 * D + h * 64; bf16* op = ATT + (size_t)row0 * D + h * 64;
        bf16x8 qf[2];
#pragma unroll
        for (int k2 = 0; k2 < 2; ++k2) qf[k2] = *(const bf16x8*)(qp + (size_t)r * D + 32 * k2 + 8 * g);
        u32x4 pre[9];
#pragma unroll
        for (int e = 0; e < 9; ++e) { const int pc = tid + 512 * e; pre[e] = *(const u32x4*)(kwin + (size_t)(pc >> 3) * D + (pc & 7) * 8); }
        __syncthreads();
        if (tid < 465) rpbs[tid] = rpb[(size_t)h * 465 + tid];
#pragma unroll
        for (int e = 0; e < 9; ++e) { const int pc = tid + 512 * e; *(LAS u32x4*)(R + (pc >> 3) * 72 + (pc & 7) * 8) = pre[e]; }
#pragma unroll
        for (int e = 0; e < 9; ++e) { const int pc = tid + 512 * e, d = pc / 72, c = pc - d * 72; pre[e] = *(const u32x4*)(vwin + (size_t)d * 1024 + c * 8); }
        __syncthreads();
        NatState st; st.m = -3e38f; st.l = 0.f;
#pragma unroll
        for (int dt = 0; dt < 4; ++dt) st.o[dt] = (f32x4){0.f, 0.f, 0.f, 0.f};
        f32x4 sc[8][2];
        nat_scores_lds<true>(r, g, qf, R + ((rbase - wstart) * 64 + cbase) * 72, 64 * 72, sc, st, rpbs, rq, rbase, cbase, 16 * n);
        __syncthreads();
#pragma unroll
        for (int e = 0; e < 9; ++e) { const int pc = tid + 512 * e, d = pc / 72, c = pc - d * 72; *(LAS u32x4*)(R + d * 584 + c * 8) = pre[e]; }
#pragma unroll
        for (int e = 0; e < 4; ++e) { const int pc = tid + 512 * e; pre[e] = *(const u32x4*)(CK + (size_t)(bl * 16 + h) * 256 * 64 + (size_t)pc * 8);
            pre[4 + e] = *(const u32x4*)(CVT + ((size_t)((bl * 16 + h) * 64) + (pc >> 5)) * 256 + (pc & 31) * 8); }
        __syncthreads();
        nat_pv_lds(r, g, R + (rbase - wstart) * 64 + cbase, 64, 584, sc, st);
        __syncthreads();
#pragma unroll
        for (int e = 0; e < 4; ++e) { const int pc = tid + 512 * e; *(LAS u32x4*)(R + (pc >> 3) * 72 + (pc & 7) * 8) = pre[e]; *(LAS u32x4*)(R + 256 * 72 + (pc >> 5) * 264 + (pc & 31) * 8) = pre[4 + e]; }
        __syncthreads();
        nat_scores_lds<false>(r, g, qf, R, 32 * 72, sc, st, rpbs, rq, rbase, cbase, 16 * n);
        nat_pv_lds(r, g, R + 256 * 72, 32, 264, sc, st);
        float lsum = st.l;
        lsum += __shfl_xor(lsum, 16); lsum += __shfl_xor(lsum, 32);
        const float inv = 1.0f / lsum;
#pragma unroll
        for (int dt = 0; dt < 4; ++dt) { u32x2 o; o.x = pk2(st.o[dt][0] * inv, st.o[dt][1] * inv); o.y = pk2(st.o[dt][2] * inv, st.o[dt][3] * inv);
            *(u32x2*)(op + (size_t)r * D + 16 * dt + 4 * g) = o; }
    }
}


__device__ __forceinline__ float gelu_tanh(float x) { const float y = 0.7978845608028654f * (x + 0.044715f * x * x * x); return x * fast_rcp(1.0f + __expf(-2.0f * y)); }
struct EpiGmlpIn {
    static constexpr bool HALF_OK = true; static constexpr bool PERM = false; static constexpr bool XPF = false;
    bf16* U; bf16* V; const float* ssq; const float* sw; float* ln1; float* ln2; float addss;
    __device__ __forceinline__ void operator()(AccRef acc, const pg8::Unit& u, int wr, int wc, int fr, int fq) const {
        const bool isu = u.pn < 4; const int colbase = (u.pn & 3) * 256 + 128 * u.bsel + wc * 32 + 4 * fq, row0 = u.pm * 256 + wr * 64 + fr;
        float rs[2][4];
#pragma unroll
        for (int ai = 0; ai < 2; ++ai)
#pragma unroll
            for (int m = 0; m < 4; ++m) rs[ai][m] = ssq[row0 + ai * 128 + m * 16];
        const float* swc = sw + (size_t)cond_of_row(u.pm * 256) * SWN + u.pn * 256 + 128 * u.bsel + wc * 32 + 4 * fq;
        f32x4 sv[2][2];
#pragma unroll
        for (int bj = 0; bj < 2; ++bj)
#pragma unroll
            for (int n = 0; n < 2; ++n) sv[bj][n] = *(const f32x4*)(swc + bj * 128 + n * 16);
#pragma unroll
        for (int ai = 0; ai < 2; ++ai)
#pragma unroll
            for (int m = 0; m < 4; ++m) { const int row = row0 + ai * 128 + m * 16; const float r1 = 1.0f / sqrtf(rs[ai][m] * (1.0f / 1024.0f) + 1e-6f); float s1 = 0.f, s2 = 0.f;
#pragma unroll
                for (int bj = 0; bj < 2; ++bj)
#pragma unroll
                    for (int n = 0; n < 2; ++n) { if (bj >= u.nb) continue; const int c = colbase + bj * 128 + n * 16; f32x4 v = acc[ai][bj][m][n] * r1 + sv[bj][n];
                        v[0] = gelu_tanh(v[0]); v[1] = gelu_tanh(v[1]); v[2] = gelu_tanh(v[2]); v[3] = gelu_tanh(v[3]);
                        if (isu) { u32x2 p; p.x = pk2(v[0], v[1]); p.y = pk2(v[2], v[3]); *(u32x2*)(U + (size_t)row * D + c) = p; }
                        else { u32x2 p; p.x = pk2(v[0], v[1]); p.y = pk2(v[2], v[3]); *(u32x2*)(V + (size_t)row * D + c) = p;
                            const f32x4 q = {bflo(p.x), bfhi(p.x), bflo(p.y), bfhi(p.y)};
                            s1 += (q[0] + q[1]) + (q[2] + q[3]); s2 += (q[0] * q[0] + q[1] * q[1]) + (q[2] * q[2] + q[3] * q[3]); } }
                if (!isu) { s1 += __shfl_xor(s1, 16); s1 += __shfl_xor(s1, 32); s2 += __shfl_xor(s2, 16); s2 += __shfl_xor(s2, 32);
                    if (fq == 0) { atomicAdd(ln1 + row, s1 * addss); atomicAdd(ln2 + row, s2 * addss); } } }
    }
};
__device__ __forceinline__ void gm_ln_phase(Frame& F, const bf16* V, const float* lg, const float* lb, bf16* VN) {
    const int gw = F.bid * NWAVES + F.wave, NGW = F.G * NWAVES;
    constexpr int RB = 5;
    f32x4 gg[4], bb[4];
#pragma unroll
    for (int j = 0; j < 4; ++j) { gg[j] = *(const f32x4*)(lg + 4 * F.lane + 256 * j); bb[j] = *(const f32x4*)(lb + 4 * F.lane + 256 * j); }
    for (int base = gw; base < M; base += RB * NGW) {
        f32x4 v[RB][4];
#pragma unroll
        for (int k = 0; k < RB; ++k) { const int row = base + k * NGW, rc = row < M ? row : gw;
#pragma unroll
            for (int j = 0; j < 4; ++j) { const u32x2 vr = *(const u32x2*)(V + (size_t)rc * D + 4 * F.lane + 256 * j); v[k][j] = (f32x4){bflo(vr.x), bfhi(vr.x), bflo(vr.y), bfhi(vr.y)}; } }
#pragma unroll
        for (int k = 0; k < RB; ++k) { const int row = base + k * NGW; float s = 0.f;
#pragma unroll
            for (int j = 0; j < 4; ++j) s += (v[k][j][0] + v[k][j][1]) + (v[k][j][2] + v[k][j][3]);
            const float mean = wave_sum(s) * (1.0f / D); float s2 = 0.f;
#pragma unroll
            for (int j = 0; j < 4; ++j) { v[k][j] = v[k][j] - mean; s2 += (v[k][j][0] * v[k][j][0] + v[k][j][1] * v[k][j][1]) + (v[k][j][2] * v[k][j][2] + v[k][j][3] * v[k][j][3]); }
            const float rstd = 1.0f / sqrtf(wave_sum(s2) * (1.0f / D) + 1e-6f);
            if (row < M) {
#pragma unroll
                for (int j = 0; j < 4; ++j) { const int c = 4 * F.lane + 256 * j; const f32x4 y = v[k][j] * rstd * gg[j] + bb[j];
                    u32x2 p; p.x = pk2(y[0], y[1]); p.y = pk2(y[2], y[3]); *(u32x2*)(VN + (size_t)row * D + c) = p; } } }
    }
}
__device__ __forceinline__ void gm_spatial_phase(Frame& F, const bf16* V, const float* ln1, const float* ln2, const float* lg, const float* lb, const bf16* U, const float* w_s, const float* b_s, bf16* MX) {
    constexpr int LS = 136;
    LAS bf16* As = (LAS bf16*)F.lds;
    LAS bf16* Bs = As + 128 * LS;
    const int tid = F.tid, r = F.lane & 15, g4 = F.lane >> 4, w = F.wave;
    for (int unit = F.bid; unit < 640; unit += F.G) { const int ch = unit >> 3, gg = unit & 7;
        __syncthreads();
#pragma unroll
        for (int e = 0; e < 8; ++e) { const int i4 = tid + 512 * e, p = i4 >> 5, q4 = (i4 & 31) * 4; const f32x4 v = *(const f32x4*)(w_s + ((size_t)gg * 128 + p) * 128 + q4);
            u32x2 o; o.x = pk2(v[0], v[1]); o.y = pk2(v[2], v[3]); *(LAS u32x2*)(As + p * LS + q4) = o; }
        { const int q0 = 8 * (tid >> 5), c4 = (tid & 31) * 4; u32x2 v[8];
          float m1[8], m2[8];
#pragma unroll
          for (int e = 0; e < 8; ++e) { v[e] = *(const u32x2*)(V + (size_t)(ch * 128 + q0 + e) * D + gg * 128 + c4); m1[e] = ln1[ch * 128 + q0 + e]; m2[e] = ln2[ch * 128 + q0 + e]; }
          const f32x4 lgv = *(const f32x4*)(lg + gg * 128 + c4), lbv = *(const f32x4*)(lb + gg * 128 + c4);
#pragma unroll
          for (int e = 0; e < 8; ++e) { const float mean = m1[e] * (1.0f / D), var = fmaxf(m2[e] * (1.0f / D) - mean * mean, 0.f), rstd = 1.0f / sqrtf(var + 1e-6f);
              const f32x4 vf = {bflo(v[e].x), bfhi(v[e].x), bflo(v[e].y), bfhi(v[e].y)};
              const f32x4 y = (vf - mean) * rstd * lgv + lbv; v[e].x = pk2(y[0], y[1]); v[e].y = pk2(y[2], y[3]); }
          u32x4 o0, o1, o2, o3;
          o0.x = (v[0].x & 0xffffu) | (v[1].x << 16); o0.y = (v[2].x & 0xffffu) | (v[3].x << 16); o0.z = (v[4].x & 0xffffu) | (v[5].x << 16); o0.w = (v[6].x & 0xffffu) | (v[7].x << 16);
          o1.x = (v[0].x >> 16) | (v[1].x & 0xffff0000u); o1.y = (v[2].x >> 16) | (v[3].x & 0xffff0000u); o1.z = (v[4].x >> 16) | (v[5].x & 0xffff0000u); o1.w = (v[6].x >> 16) | (v[7].x & 0xffff0000u);
          o2.x = (v[0].y & 0xffffu) | (v[1].y << 16); o2.y = (v[2].y & 0xffffu) | (v[3].y << 16); o2.z = (v[4].y & 0xffffu) | (v[5].y << 16); o2.w = (v[6].y & 0xffffu) | (v[7].y << 16);
          o3.x = (v[0].y >> 16) | (v[1].y & 0xffff0000u); o3.y = (v[2].y >> 16) | (v[3].y & 0xffff0000u); o3.z = (v[4].y >> 16) | (v[5].y & 0xffff0000u); o3.w = (v[6].y >> 16) | (v[7].y & 0xffff0000u);
          *(LAS u32x4*)(Bs + (c4 + 0) * LS + q0) = o0; *(LAS u32x4*)(Bs + (c4 + 1) * LS + q0) = o1; *(LAS u32x4*)(Bs + (c4 + 2) * LS + q0) = o2; *(LAS u32x4*)(Bs + (c4 + 3) * LS + q0) = o3; }
        const int p = 16 * w + r, tok = ch * 128 + p; const float bsv = b_s[gg * 128 + p];
        u32x2 uu[8];
#pragma unroll
        for (int ct = 0; ct < 8; ++ct) uu[ct] = *(const u32x2*)(U + (size_t)tok * D + gg * 128 + 16 * ct + 4 * g4);
        __syncthreads();
        f32x4 acc[8];
#pragma unroll
        for (int ct = 0; ct < 8; ++ct) acc[ct] = (f32x4){0.f, 0.f, 0.f, 0.f};
#pragma unroll
        for (int k4 = 0; k4 < 4; ++k4) { const bf16x8 af = *(const LAS bf16x8*)(As + (16 * w + r) * LS + 32 * k4 + 8 * g4);
#pragma unroll
            for (int ct = 0; ct < 8; ++ct) { const bf16x8 bf = *(const LAS bf16x8*)(Bs + (16 * ct + r) * LS + 32 * k4 + 8 * g4);
                acc[ct] = __builtin_amdgcn_mfma_f32_16x16x32_bf16(bf, af, acc[ct], 0, 0, 0); } }
#pragma unroll
        for (int ct = 0; ct < 8; ++ct) { const int c = gg * 128 + 16 * ct + 4 * g4;
            u32x2 o; o.x = pk2((acc[ct][0] + bsv) * bflo(uu[ct].x), (acc[ct][1] + bsv) * bfhi(uu[ct].x)); o.y = pk2((acc[ct][2] + bsv) * bflo(uu[ct].y), (acc[ct][3] + bsv) * bfhi(uu[ct].y));
            *(u32x2*)(MX + (size_t)tok * D + c) = o; }
    }
}

struct EpiSsdIn {
    static constexpr bool HALF_OK = true; static constexpr bool PERM = false; static constexpr bool XPF = false;
    bf16* Z; bf16* XBC; float* DT; const float* ssq; const float* sw;
    __device__ __forceinline__ void operator()(AccRef acc, const pg8::Unit& u, int wr, int wc, int fr, int fq) const {
        const int row0 = u.pm * 256 + wr * 64 + fr, cl = 128 * u.bsel + wc * 32 + 4 * fq;
        float rs[2][4];
#pragma unroll
        for (int ai = 0; ai < 2; ++ai)
#pragma unroll
            for (int m = 0; m < 4; ++m) rs[ai][m] = ssq[row0 + ai * 128 + m * 16];
        const float* swc = sw + (size_t)cond_of_row(u.pm * 256) * SWN + u.pn * 256 + cl;
        f32x4 sv[2][2];
#pragma unroll
        for (int bj = 0; bj < 2; ++bj)
#pragma unroll
            for (int n = 0; n < 2; ++n) sv[bj][n] = *(const f32x4*)(swc + bj * 128 + n * 16);
        if (u.pn < 20) {
            bf16* base; int ld, c0;
            if (u.pn < 8) { base = Z; ld = 2048; c0 = u.pn * 256; } else { base = XBC; ld = 3072; c0 = (u.pn - 8) * 256; }
#pragma unroll
            for (int ai = 0; ai < 2; ++ai)
#pragma unroll
                for (int m = 0; m < 4; ++m) { bf16* rowp = base + (size_t)(row0 + ai * 128 + m * 16) * ld + c0 + cl; const float r1 = 1.0f / sqrtf(rs[ai][m] * (1.0f / 1024.0f) + 1e-6f);
#pragma unroll
                    for (int bj = 0; bj < 2; ++bj)
#pragma unroll
                        for (int n = 0; n < 2; ++n) { if (bj >= u.nb) continue; const f32x4 v = acc[ai][bj][m][n] * r1 + sv[bj][n]; u32x2 o; o.x = pk2(v[0], v[1]); o.y = pk2(v[2], v[3]); *(u32x2*)(rowp + bj * 128 + n * 16) = o; } }
        } else {
#pragma unroll
            for (int ai = 0; ai < 2; ++ai)
#pragma unroll
                for (int m = 0; m < 4; ++m) { float* rowp = DT + (size_t)(row0 + ai * 128 + m * 16) * 64 + cl; const float r1 = 1.0f / sqrtf(rs[ai][m] * (1.0f / 1024.0f) + 1e-6f);
#pragma unroll
                    for (int n = 0; n < 2; ++n) { if (cl + n * 16 < 64) *(f32x4*)(rowp + n * 16) = acc[ai][0][m][n] * r1 + sv[0][n]; } }
        }
    }
};
__device__ __forceinline__ void ssd_conv_phase(Frame& F, const bf16* XBC, const float* DT, float* DTS, float* PCS, const float* alog, const float* cw, const float* cb, const float* dtb, bf16* XT, bf16* BMb, bf16* CMb, bf16* BMT) {
    LAS bf16* tl = (LAS bf16*)F.lds;
    const int tid = F.tid, c2 = (tid & 63) * 2, tg = tid >> 6;
    for (int task = F.bid * NWAVES + F.wave; task < 160 * 64; task += F.G * NWAVES) { const int ch = task >> 6, col = task & 63, dirc = col >> 5; const size_t idx = (size_t)(ch * 64 + F.lane) * 64 + col;
        const float x = DT[idx] + dtb[col]; const float dt = fmaxf(x, 0.f) + log1pf(expf(-fabsf(x))); DTS[idx] = dt;
        float v = dt * -expf(alog[col]);
        if (dirc == 0) {
#pragma unroll
            for (int o = 1; o < 64; o <<= 1) { const float t = __shfl_up(v, o); if (F.lane >= o) v += t; }
        } else {
#pragma unroll
            for (int o = 1; o < 64; o <<= 1) { const float t = __shfl_down(v, o); if (F.lane + o < 64) v += t; }
        }
        PCS[idx] = v; }
    for (int unit = F.bid; unit < 160 * 24; unit += F.G) { const int tb = unit / 24, cbk = unit % 24, ch = cbk * 128 + c2;
        const f32x2 w0 = *(const f32x2*)(cw + ch), w1 = *(const f32x2*)(cw + 3072 + ch), w2 = *(const f32x2*)(cw + 6144 + ch), bb = *(const f32x2*)(cb + ch);
        const int row0 = tb * 64 + tg * 8;
        const int T = row0 < NCTX ? 256 : 1024, pos0 = row0 < NCTX ? (row0 & 255) : ((row0 - NCTX) & 1023);
        unsigned raw[10];
#pragma unroll
        for (int j = 0; j < 10; ++j) { const int pos = pos0 - 1 + j; const bool ok = pos >= 0 && pos < T; const int rr = ok ? row0 - 1 + j : row0; raw[j] = *(const unsigned*)(XBC + (size_t)rr * 3072 + ch); }
        float xa[10], xb[10];
#pragma unroll
        for (int j = 0; j < 10; ++j) { const int pos = pos0 - 1 + j; const bool ok = pos >= 0 && pos < T; xa[j] = ok ? bflo(raw[j]) : 0.f; xb[j] = ok ? bfhi(raw[j]) : 0.f; }
        unsigned yp[8];
#pragma unroll
        for (int j = 0; j < 8; ++j) yp[j] = pk2(silu_f(w0.x * xa[j] + w1.x * xa[j + 1] + w2.x * xa[j + 2] + bb.x), silu_f(w0.y * xb[j] + w1.y * xb[j + 1] + w2.y * xb[j + 2] + bb.y));
        __syncthreads();
        if (cbk >= 16 && cbk < 20) {
#pragma unroll
            for (int j = 0; j < 8; ++j) *(unsigned*)(BMb + (size_t)(row0 + j) * 512 + ch - 2048) = yp[j];
        } else if (cbk >= 20) {
#pragma unroll
            for (int j = 0; j < 8; ++j) *(unsigned*)(CMb + (size_t)(row0 + j) * 512 + ch - 2560) = yp[j];
        }
        if (cbk < 20) {
            u32x4 lo4, hi4;
            lo4.x = (yp[0] & 0xffffu) | (yp[1] << 16); lo4.y = (yp[2] & 0xffffu) | (yp[3] << 16); lo4.z = (yp[4] & 0xffffu) | (yp[5] << 16); lo4.w = (yp[6] & 0xffffu) | (yp[7] << 16);
            hi4.x = (yp[0] >> 16) | (yp[1] & 0xffff0000u); hi4.y = (yp[2] >> 16) | (yp[3] & 0xffff0000u); hi4.z = (yp[4] >> 16) | (yp[5] & 0xffff0000u); hi4.w = (yp[6] >> 16) | (yp[7] & 0xffff0000u);
            *(LAS u32x4*)(tl + c2 * 72 + tg * 8) = lo4; *(LAS u32x4*)(tl + (c2 + 1) * 72 + tg * 8) = hi4;
        }
        __syncthreads();
        if (cbk < 20) {
#pragma unroll
            for (int e = 0; e < 2; ++e) { const int pc = tid + 512 * e, rowc = pc >> 3, part = pc & 7; const u32x4 v = *(const LAS u32x4*)(tl + rowc * 72 + part * 8);
                bf16* dst = cbk < 16 ? XT + (size_t)(cbk * 128 + rowc) * M : BMT + (size_t)((cbk - 16) * 128 + rowc) * M;
                *(u32x4*)(dst + tb * 64 + part * 8) = v; }
        }
    }
}
__device__ __forceinline__ void ssd_unit(Frame& F, bool latent, int uid, const float* DT, const float* PCS, const bf16* XT, const bf16* BMb, const bf16* CMb, const bf16* BMT,
                                         const float* state_in, float* state_out, bf16* Y, const float* dsk) {
    constexpr int S1 = 136, S2 = 72;
    LAS bf16* cmS = (LAS bf16*)F.lds;
    LAS bf16* bmS = cmS + 64 * S1;
    LAS bf16* bmT = bmS + 64 * S1;
    LAS bf16* xTb = bmT + 128 * S2;
    LAS bf16* xTw = xTb + 2 * 64 * S2;
    LAS bf16* Mtb = xTw + 2 * 64 * S2;
    LAS bf16* Sbb = Mtb + 2 * 64 * S2;
    LAS float* Pc = (LAS float*)(Sbb + 2 * 64 * S1);
    LAS float* dtv = Pc + 128; LAS float* wv = dtv + 128; LAS float* ep = wv + 128; LAS float* misc = ep + 128;
    const int tid = F.tid, lane = F.lane, w = F.wave, r = lane & 15, g4 = lane >> 4;
    const int dir = uid & 1, hp = (uid >> 1) & 15, b = uid >> 5, hd0 = 2 * hp, grp = hd0 >> 3;
    const int T = latent ? 1024 : 256, nch = T / 64, seqbase = latent ? NCTX + b * 1024 : b * 256;
    const float dk0 = dsk[hd0], dk1 = dsk[hd0 + 1];
    f32x4 S[2][4];
    __syncthreads();
#pragma unroll
    for (int hh = 0; hh < 2; ++hh)
#pragma unroll
        for (int pt = 0; pt < 4; ++pt) {
            if (latent) S[hh][pt] = *(const f32x4*)(state_in + ((size_t)((b * 2 + dir) * 32 + hd0 + hh) * 64 + 16 * pt + r) * 128 + 16 * w + 4 * g4);
            else S[hh][pt] = (f32x4){0.f, 0.f, 0.f, 0.f};
            u32x2 o; o.x = pk2(S[hh][pt][0], S[hh][pt][1]); o.y = pk2(S[hh][pt][2], S[hh][pt][3]); *(LAS u32x2*)(Sbb + hh * 64 * S1 + (16 * pt + r) * S1 + 16 * w + 4 * g4) = o; }
    u32x4 pcm[2], pbm[2], pbt[2], pxt[2]; float pdt = 0.f, ppc = 0.f;
#define SSD_LOAD(c_) do { const int cc_ = dir == 0 ? (c_) : nch - 1 - (c_); const int rg_ = seqbase + cc_ * 64; \
        _Pragma("unroll") for (int e = 0; e < 2; ++e) { const int pc = tid + 512 * e, row = pc >> 4, c8 = (pc & 15) * 8; \
            pcm[e] = *(const u32x4*)(CMb + (size_t)(rg_ + row) * 512 + grp * 128 + c8); pbm[e] = *(const u32x4*)(BMb + (size_t)(rg_ + row) * 512 + grp * 128 + c8); } \
        _Pragma("unroll") for (int e = 0; e < 2; ++e) { const int pc = tid + 512 * e, row = pc >> 3, c8 = (pc & 7) * 8; pbt[e] = *(const u32x4*)(BMT + (size_t)(grp * 128 + row) * M + rg_ + c8); } \
        _Pragma("unroll") for (int e = 0; e < 2; ++e) { const int pc = tid + 512 * e, row = pc >> 3, c8 = (pc & 7) * 8; pxt[e] = *(const u32x4*)(XT + (size_t)(hd0 * 64 + row) * M + rg_ + c8); } \
        if (w < 2) { const size_t di_ = (size_t)(rg_ + (tid & 63)) * 64 + dir * 32 + hd0 + ((tid >> 6) & 1); pdt = DT[di_]; ppc = PCS[di_]; } } while (0)
    SSD_LOAD(0);
#define SSD_STAGE() do { \
        _Pragma("unroll") for (int e = 0; e < 2; ++e) { const int pc = tid + 512 * e, row = pc >> 4, c8 = (pc & 15) * 8; \
            *(LAS u32x4*)(cmS + row * S1 + c8) = pcm[e]; *(LAS u32x4*)(bmS + row * S1 + c8) = pbm[e]; } \
        _Pragma("unroll") for (int e = 0; e < 2; ++e) { const int pc = tid + 512 * e, row = pc >> 3, c8 = (pc & 7) * 8; *(LAS u32x4*)(bmT + row * S2 + c8) = pbt[e]; *(LAS u32x4*)(xTb + row * S2 + c8) = pxt[e]; } \
        { const float tot = __shfl(ppc, dir == 0 ? 63 : 0); \
          if (w < 2) { Pc[tid] = ppc; dtv[tid] = pdt; wv[tid] = __expf(tot - ppc) * pdt; ep[tid] = __expf(ppc); if (lane == 0) misc[w] = __expf(tot); } } } while (0)
    SSD_STAGE();
    if (1 < nch) SSD_LOAD(1);
    for (int c = 0; c < nch; ++c) {
        const int cc = dir == 0 ? c : nch - 1 - c, rowg = seqbase + cc * 64;
        __syncthreads();
        { const int ti = w >> 1;
#pragma unroll
          for (int jj = 0; jj < 2; ++jj) { const int tj = 2 * (w & 1) + jj; f32x4 a = {0.f, 0.f, 0.f, 0.f};
#pragma unroll
              for (int k4 = 0; k4 < 4; ++k4) { const bf16x8 af = *(const LAS bf16x8*)(bmS + (16 * tj + r) * S1 + 32 * k4 + 8 * g4), bf = *(const LAS bf16x8*)(cmS + (16 * ti + r) * S1 + 32 * k4 + 8 * g4);
                  a = __builtin_amdgcn_mfma_f32_16x16x32_bf16(af, bf, a, 0, 0, 0); }
              const int tau = 16 * ti + r;
#pragma unroll
              for (int hh = 0; hh < 2; ++hh) { const float pt_ = Pc[hh * 64 + tau]; const f32x4 pp = *(const LAS f32x4*)(Pc + hh * 64 + 16 * tj + 4 * g4), dd = *(const LAS f32x4*)(dtv + hh * 64 + 16 * tj + 4 * g4); float mv[4];
#pragma unroll
                  for (int e = 0; e < 4; ++e) { const int tp = 16 * tj + 4 * g4 + e; const bool ok = dir == 0 ? (tp <= tau) : (tp >= tau);
                      mv[e] = ok ? a[e] * __expf(pt_ - pp[e]) * dd[e] : 0.f; }
                  u32x2 o; o.x = pk2(mv[0], mv[1]); o.y = pk2(mv[2], mv[3]); *(LAS u32x2*)(Mtb + hh * 64 * S2 + tau * S2 + 16 * tj + 4 * g4) = o; } } }
#pragma unroll
        for (int e = 0; e < 2; ++e) { const int pc = tid + 512 * e, row = pc >> 3, c8 = (pc & 7) * 8, hh = row >> 6;
            const u32x4 xv = *(const LAS u32x4*)(xTb + row * S2 + c8); const f32x4 w0 = *(const LAS f32x4*)(wv + hh * 64 + c8), w1 = *(const LAS f32x4*)(wv + hh * 64 + c8 + 4);
            u32x4 o; o.x = pk2(bflo(xv.x) * w0[0], bfhi(xv.x) * w0[1]); o.y = pk2(bflo(xv.y) * w0[2], bfhi(xv.y) * w0[3]); o.z = pk2(bflo(xv.z) * w1[0], bfhi(xv.z) * w1[1]); o.w = pk2(bflo(xv.w) * w1[2], bfhi(xv.w) * w1[3]);
            *(LAS u32x4*)(xTw + row * S2 + c8) = o; }
        __syncthreads();
        { const int hh = w >> 2, ti = w & 3, tau = 16 * ti + r; const float epv = ep[hh * 64 + tau];
          const LAS bf16* xT = xTb + hh * 64 * S2; const LAS bf16* Mt = Mtb + hh * 64 * S2; const LAS bf16* Sb = Sbb + hh * 64 * S1;
#pragma unroll
          for (int pt = 0; pt < 4; ++pt) { f32x4 ad = {0.f, 0.f, 0.f, 0.f}, ao = {0.f, 0.f, 0.f, 0.f};
#pragma unroll
              for (int k2 = 0; k2 < 2; ++k2) { const bf16x8 af = *(const LAS bf16x8*)(xT + (16 * pt + r) * S2 + 32 * k2 + 8 * g4), bf = *(const LAS bf16x8*)(Mt + tau * S2 + 32 * k2 + 8 * g4);
                  ad = __builtin_amdgcn_mfma_f32_16x16x32_bf16(af, bf, ad, 0, 0, 0); }
#pragma unroll
              for (int k4 = 0; k4 < 4; ++k4) { const bf16x8 af = *(const LAS bf16x8*)(Sb + (16 * pt + r) * S1 + 32 * k4 + 8 * g4), bf = *(const LAS bf16x8*)(cmS + tau * S1 + 32 * k4 + 8 * g4);
                  ao = __builtin_amdgcn_mfma_f32_16x16x32_bf16(af, bf, ao, 0, 0, 0); }
              { f32x4 yv = ad + ao * epv;
                if (dir == 0) { const float dk = hh == 0 ? dk0 : dk1;
#pragma unroll
                    for (int e = 0; e < 4; ++e) yv[e] += dk * bf2f(xT[(16 * pt + 4 * g4 + e) * S2 + tau]); }
                u32x2 o; o.x = pk2(yv[0], yv[1]); o.y = pk2(yv[2], yv[3]); *(u32x2*)(Y + ((size_t)dir * M + rowg + tau) * 2048 + (hd0 + hh) * 64 + 16 * pt + 4 * g4) = o; } } }
#pragma unroll
        for (int hh = 0; hh < 2; ++hh) { const float dec = misc[hh];
#pragma unroll
          for (int pt = 0; pt < 4; ++pt) { f32x4 a = {0.f, 0.f, 0.f, 0.f};
#pragma unroll
              for (int k2 = 0; k2 < 2; ++k2) { const bf16x8 af = *(const LAS bf16x8*)(bmT + (16 * w + r) * S2 + 32 * k2 + 8 * g4), bf = *(const LAS bf16x8*)(xTw + hh * 64 * S2 + (16 * pt + r) * S2 + 32 * k2 + 8 * g4);
                  a = __builtin_amdgcn_mfma_f32_16x16x32_bf16(af, bf, a, 0, 0, 0); }
              S[hh][pt] = S[hh][pt] * dec + a; } }
        __syncthreads();
#pragma unroll
        for (int hh = 0; hh < 2; ++hh)
#pragma unroll
          for (int pt = 0; pt < 4; ++pt) { u32x2 o; o.x = pk2(S[hh][pt][0], S[hh][pt][1]); o.y = pk2(S[hh][pt][2], S[hh][pt][3]); *(LAS u32x2*)(Sbb + hh * 64 * S1 + (16 * pt + r) * S1 + 16 * w + 4 * g4) = o; }
        if (c + 1 < nch) { SSD_STAGE(); if (c + 2 < nch) SSD_LOAD(c + 2); }
    }
#undef SSD_STAGE
#undef SSD_LOAD
    if (!latent) {
#pragma unroll
        for (int hh = 0; hh < 2; ++hh)
#pragma unroll
            for (int pt = 0; pt < 4; ++pt) __builtin_nontemporal_store(S[hh][pt], (f32x4*)(state_out + ((size_t)((b * 2 + dir) * 32 + hd0 + hh) * 64 + 16 * pt + r) * 128 + 16 * w + 4 * g4));
    }
}
__device__ __forceinline__ void ssd_core_phase(Frame& F, const float* DT, const float* PCS, const bf16* XT, const bf16* BMb, const bf16* CMb, const bf16* BMT, const float* state_in, float* state_out, bf16* Y, const float* dsk) {
    if (F.G == 256) {
        if (F.bid < 64) { ssd_unit(F, true, F.bid, DT, PCS, XT, BMb, CMb, BMT, state_in, state_out, Y, dsk); ssd_unit(F, false, F.bid, DT, PCS, XT, BMb, CMb, BMT, state_in, state_out, Y, dsk); }
        else { for (int j = 0; j < 5; ++j) ssd_unit(F, false, 64 + 5 * (F.bid - 64) + j, DT, PCS, XT, BMb, CMb, BMT, state_in, state_out, Y, dsk); }
    } else {
        for (int u = F.bid; u < 64 + 1024; u += F.G) ssd_unit(F, u < 64, u < 64 ? u : u - 64, DT, PCS, XT, BMb, CMb, BMT, state_in, state_out, Y, dsk);
    }
}
__device__ __forceinline__ void ssd_combine_phase(Frame& F, const bf16* Y, const bf16* Z, const float* gn, bf16* YN) {
    const int gw = F.bid * NWAVES + F.wave, NGW = F.G * NWAVES;
    constexpr int RB = 2;
    for (int base = gw; base < M; base += RB * NGW) {
        u32x2 yf[RB][8], yb[RB][8], zz[RB][8];
#pragma unroll
        for (int k = 0; k < RB; ++k) { const int row = base + k * NGW, rc = row < M ? row : gw;
#pragma unroll
            for (int j = 0; j < 8; ++j) { const int c = 256 * j + 4 * F.lane; yf[k][j] = *(const u32x2*)(Y + (size_t)rc * 2048 + c); yb[k][j] = *(const u32x2*)(Y + ((size_t)M + rc) * 2048 + c); zz[k][j] = *(const u32x2*)(Z + (size_t)rc * 2048 + c); } }
#pragma unroll
        for (int k = 0; k < RB; ++k) { const int row = base + k * NGW; f32x4 y[8]; float ss = 0.f;
#pragma unroll
            for (int j = 0; j < 8; ++j) {
                const f32x4 a = {bflo(yf[k][j].x) + bflo(yb[k][j].x), bfhi(yf[k][j].x) + bfhi(yb[k][j].x), bflo(yf[k][j].y) + bflo(yb[k][j].y), bfhi(yf[k][j].y) + bfhi(yb[k][j].y)};
                const f32x4 z = {bflo(zz[k][j].x), bfhi(zz[k][j].x), bflo(zz[k][j].y), bfhi(zz[k][j].y)};
                f32x4 v; v[0] = a[0] * silu_f(z[0]); v[1] = a[1] * silu_f(z[1]); v[2] = a[2] * silu_f(z[2]); v[3] = a[3] * silu_f(z[3]);
                y[j] = v; ss += (v[0] * v[0] + v[1] * v[1]) + (v[2] * v[2] + v[3] * v[3]); }
            const float rstd = 1.0f / sqrtf(wave_sum(ss) * (1.0f / 2048.0f) + 1e-6f);
            if (row < M) {
#pragma unroll
                for (int j = 0; j < 8; ++j) { const int c = 256 * j + 4 * F.lane; const f32x4 v = y[j] * rstd * *(const f32x4*)(gn + c);
                    u32x2 p; p.x = pk2(v[0], v[1]); p.y = pk2(v[2], v[3]); *(u32x2*)(YN + (size_t)row * 2048 + c) = p; } } }
    }
}

__global__ void __launch_bounds__(NT, 2) fwd_kernel(Args args) {
    extern __shared__ __attribute__((aligned(16))) unsigned char lds_raw[];
    Frame F;
    F.lds = (LAS unsigned char*)lds_raw;
    F.tid = threadIdx.x; F.lane = F.tid & 63; F.wave = __builtin_amdgcn_readfirstlane(F.tid >> 6);
    F.G = gridDim.x; F.bid = blockIdx.x;
    F.in = args.in; F.out = args.out; F.ws = args.ws;
    unsigned char* ws = args.ws;
    for (int u = F.tid; u < (LDS_BYTES - LDSCTL_OFF) / 4; u += NT) ((LAS unsigned*)(F.lds + LDSCTL_OFF))[u] = 0u;
    __syncthreads();
    volatile LAS unsigned* MISC = (volatile LAS unsigned*)(F.lds + MISC_OFF);
    unsigned* ctl = (unsigned*)(ws + WS_CTL);
    XcdBarrier bar; bar.bar = ctl + CW_BAR; bar.x = 0; bar.st = nullptr;
    if (!MK_PER_PHASE) bar = xcd_barrier_post(ctl + CW_BAR, MISC + 8);
    const int lo = args.ph_lo, hi = args.ph_hi;
    int ph = 0;
#ifndef PROBE_MASK
#define PROBE_MASK 0ull
#endif
#ifndef PROBE_BARX
#define PROBE_BARX 0
#define PROBE_ALLCONV 0
#endif
#ifdef DBG_ONLY
#define PHASE_GUARD (ph == DBG_ONLY && lo <= ph && ph < hi)
#else
#define PHASE_GUARD (lo <= ph && ph < hi)
#endif
#define PHASE(...) { if (PHASE_GUARD) { \
        if (((unsigned long long)(PROBE_MASK) >> ph) & 1ull) { const float rc_ = 0.0f; (void)rc_; asm volatile("" : "+v"(F.tid), "+v"(F.lane)); __VA_ARGS__; if (!MK_PER_PHASE) xcd_barrier(bar); } \
        { const float rc_ = 1.0f; (void)rc_; asm volatile("" : "+v"(F.tid), "+v"(F.lane)); __VA_ARGS__; } \
        if (!MK_PER_PHASE && ph + 1 < hi) { xcd_barrier(bar); if (PROBE_BARX) xcd_barrier(bar); } } ++ph; }

    float* MOD = (float*)(ws + WS_MOD);
    bf16* X = (bf16*)(ws + WS_X);
    bf16* H = (bf16*)(ws + WS_H);
    bf16* HID = (bf16*)(ws + WS_HID);
    float* SSQ0 = (float*)(ws + WS_CTL + 512 * 1024); float* SSQ1 = SSQ0 + 16384; const float* SWB = (const float*)(ws + WS_SW);
    const float* const* in = args.in;

    PHASE( p0_phase(F); )
    PHASE( first_norm_phase(F, in[0], in[1], X, in[8], MOD + D, H, SSQ0); )

#define RUN_GEMM(gid, Aptr, Bptr, NN, KK, ...) { pg8::Gemm g{Aptr, Bptr, M, NN, KK}; pg8::TileOrder S; __VA_ARGS__; S.init(M, NN, F.G, F.bid, decltype(E)::HALF_OK, (gid) == 16); pg8::gemm_phase(F.lds, g, S, E, F.tid); }
#define IDLE_CONV(grp) if ((grp) >= 0 && rc_ == 1.0f) {   \
        if (F.G == 256 && !PROBE_ALLCONV) { if (F.bid >= 160) conv_group<((grp) >= 0 ? (grp) : 15)>(F, (F.bid - 160) * NWAVES + F.wave, 96 * NWAVES); } \
        else { conv_group<((grp) >= 0 ? (grp) : 15)>(F, F.bid * NWAVES + F.wave, F.G * NWAVES); __syncthreads(); } }
#define SSQ_R(p) ((p) % 2 == 0 ? SSQ0 : SSQ1)
#define SSQ_W(p) ((p) % 2 == 0 ? SSQ1 : SSQ0)
#define ZERO_SSQ(p) { if (F.bid < 40) { float* z_ = SSQ_W(p) + F.bid * 256; if (F.tid < 256) z_[F.tid] = 0.f; } }
#define FFN_BLOCK(l, half, grp) { \
    constexpr int sub_ = (half) == 0 ? 0 : 2; constexpr int pr_ = 3 * (l) + ((half) == 0 ? 0 : 2); const float* modl_ = MOD + (size_t)(l) * 3 * NMOD; \
    PHASE( { ZERO_SSQ(pr_) \
        RUN_GEMM(((l) * 2 + (half)) * 2, H, (const bf16*)(ws + WS_WFI) + (size_t)((l) * 2 + (half)) * 5632 * 1024, 5632, 1024, EpiSwiglu E{HID, SSQ_R(pr_), SWB + (size_t)((l) * 2 + (half)) * 3 * SWN, F.lds}) } \
    ) \
    PHASE( { IDLE_CONV(grp) \
        constexpr int ln_ = (half) == 0 ? (l) : (l) + 1, sn_ = (half) == 0 ? 1 : 0; \
        RUN_GEMM(((l) * 2 + (half)) * 2 + 1, HID, (const bf16*)(ws + WS_WFO) + (size_t)((l) * 2 + (half)) * 1024 * 2816, 1024, 2816, \
                 EpiResid<(ln_ < 4)> E{X, modl_ + (size_t)(3 * sub_ + 2) * D, in[8] + (size_t)((ln_ < 4 ? ln_ : 0) * 3 + sn_) * D, MOD + (size_t)(ln_ < 4 ? ln_ : 0) * 3 * NMOD + (size_t)(3 * sn_ + 1) * D, H, SSQ_W(pr_), F.lds, F.G >= 160, 0.5f * rc_, rc_}) } \
    ) }

#define OUT_GEMM(l, Aptr, Wptr, KK, grp) PHASE( { IDLE_CONV(grp) \
        RUN_GEMM(17 + 2 * (l), Aptr, Wptr, 1024, KK, EpiResid<true> E{X, MOD + (size_t)(l) * 3 * NMOD + 5 * D, in[8] + (size_t)((l) * 3 + 2) * D, MOD + (size_t)(l) * 3 * NMOD + 7 * D, H, SSQ_W(3 * (l) + 1), F.lds, F.G >= 160, rc_, rc_}) } )
    unsigned char* R = ws + WS_R;
    float* out = args.out;

    FFN_BLOCK(0, 0, 1)
    {
        bf16* PROJ = (bf16*)R; bf16* O = (bf16*)(R + 130 * MiB); bf16* Gb = (bf16*)(R + 210 * MiB);
        PHASE( { ZERO_SSQ(1) RUN_GEMM(16, H, (const bf16*)(ws + WS_WGI), GLA_NP, 1024, EpiBf16Plain E{PROJ, GLA_NP, SSQ_R(1), SWB + (size_t)8 * 3 * SWN}) } )
        PHASE( gla_prep_phase(F, PROJ, R + 232 * MiB, in[15], in[16], (const float*)(ws + WS_ROPE), (const float*)(ws + WS_ROPE) + 65536); )
        PHASE( gla_core_phase(F, PROJ, R + 232 * MiB, O, in[2], out + 10485760); )
        PHASE( gla_combine_phase(F, PROJ, O, in[17], Gb); )
        OUT_GEMM(0, Gb, (const bf16*)(ws + WS_WGO), 1024, 2)
    }
    FFN_BLOCK(0, 1, 3)
    FFN_BLOCK(1, 0, 4)
    {
        bf16* Qb = (bf16*)R; bf16* Kb = (bf16*)(R + 20 * MiB); bf16* VTC = (bf16*)(R + 40 * MiB); bf16* VTL = (bf16*)(R + 56 * MiB); bf16* ATT = (bf16*)(R + 60 * MiB);
        PHASE( { ZERO_SSQ(4) RUN_GEMM(18, H, (const bf16*)(ws + WS_WNI), 3072, 1024, EpiNatQKV E{Qb, Kb, VTC, VTL, out + 18874368, out + 27262976, SSQ_R(4), SWB + (size_t)9 * 3 * SWN}) } )
        PHASE( nat_attn_phase(F, Qb, Kb, VTC, VTL, (const bf16*)(ws + WS_CK), (const bf16*)(ws + WS_CVT), in[20], ATT); )
        OUT_GEMM(1, ATT, (const bf16*)(ws + WS_WNO), 1024, 5)
    }
    FFN_BLOCK(1, 1, 6)
    FFN_BLOCK(2, 0, 7)
    {
        bf16* Ub = (bf16*)R; bf16* Vf = (bf16*)(R + 20 * MiB); bf16* VN = (bf16*)(R + 60 * MiB); bf16* MX = (bf16*)(R + 80 * MiB);
        float* LN1 = (float*)(ws + WS_CTL + 640 * 1024); float* LN2 = LN1 + 16384;
        PHASE( { ZERO_SSQ(7) RUN_GEMM(20, H, (const bf16*)(ws + WS_WMI), 2048, 1024, EpiGmlpIn E{Ub, Vf, SSQ_R(7), SWB + (size_t)10 * 3 * SWN, LN1, LN2, rc_}) } )
        PHASE( gm_spatial_phase(F, Vf, LN1, LN2, in[23], in[24], Ub, in[25], in[26], MX); )
        OUT_GEMM(2, MX, (const bf16*)(ws + WS_WMO), 1024, 8)
    }
    FFN_BLOCK(2, 1, 9)
    FFN_BLOCK(3, 0, -1)
    {
        bf16* XBC = (bf16*)R; float* DT = (float*)(R + 60 * MiB); bf16* Zb = (bf16*)(R + 104 * MiB); float* DTS = (float*)(R + 144 * MiB); float* PCS = (float*)(R + 147 * MiB); bf16* XT = (bf16*)(R + 187 * MiB);
        bf16* BMb = (bf16*)(R + 227 * MiB); bf16* CMb = (bf16*)(R + 237 * MiB); bf16* BMT = (bf16*)(R + 247 * MiB); bf16* YN = (bf16*)(R + 257 * MiB);
        bf16* Y = (bf16*)(ws + WS_HID);
        PHASE( { ZERO_SSQ(10) RUN_GEMM(22, H, (const bf16*)(ws + WS_WSI), SSD_NP, 1024, EpiSsdIn E{Zb, XBC, DT, SSQ_R(10), SWB + (size_t)11 * 3 * SWN}) } )
        PHASE( ssd_conv_phase(F, XBC, DT, DTS, PCS, in[32], in[29], in[30], in[31], XT, BMb, CMb, BMT); )
        PHASE( ssd_core_phase(F, DTS, PCS, XT, BMb, CMb, BMT, in[5], out + 35651584, Y, in[33]); )
        PHASE( ssd_combine_phase(F, Y, Zb, in[34], YN); )
        OUT_GEMM(3, YN, (const bf16*)(ws + WS_WSO), 2048, -1)
    }
    FFN_BLOCK(3, 1, -1)
    PHASE( final_norm_phase(F, X, in[36], F.out); )
}

constexpr int N_PHASES = 2 + 9 + 7 + 7 + 9 + 1;

extern "C" void kernel_launch(void* const* d_in, const int* in_sizes, int n_in, void* d_out, int out_size, void* d_ws, size_t ws_size, hipStream_t stream) {
    static int grid = 0;
    if (grid == 0) {
        if (n_in != 37 || ws_size < WS_END) { fprintf(stderr, "kernel_launch: unexpected n_in %d / ws %zu\n", n_in, ws_size); grid = -1; return; }
        int dev = 0, cus = 0;
        if (hipGetDevice(&dev) != hipSuccess || hipDeviceGetAttribute(&cus, hipDeviceAttributeMultiprocessorCount, dev) != hipSuccess) { grid = -1; return; }
        if (hipFuncSetAttribute((const void*)fwd_kernel, hipFuncAttributeMaxDynamicSharedMemorySize, LDS_BYTES) != hipSuccess) { fprintf(stderr, "kernel_launch: hipFuncSetAttribute failed\n"); grid = -1; return; }
        int per_cu = 0;
        if (hipOccupancyMaxActiveBlocksPerMultiprocessor(&per_cu, (const void*)fwd_kernel, NT, LDS_BYTES) != hipSuccess || per_cu < 1) fprintf(stderr, "kernel_launch: occupancy query says %d\n", per_cu);
        (void)hipGetLastError();
        grid = cus;
    }
    if (grid < 0) return;
    (void)hipMemsetAsync((char*)d_ws + WS_CTL, 0, CTL_ZERO_BYTES, stream);
    Args a{};
    for (int i = 0; i < 37; ++i) a.in[i] = (const float*)d_in[i];
    a.out = (float*)d_out; a.ws = (unsigned char*)d_ws;
#if MK_PER_PHASE
    for (int p = 0; p < N_PHASES; ++p) { a.ph_lo = p; a.ph_hi = p + 1; hipLaunchKernelGGL(fwd_kernel, dim3(grid), dim3(NT), LDS_BYTES, stream, a); }
#else
    a.ph_lo = 0; a.ph_hi = N_PHASES;
    hipLaunchKernelGGL(fwd_kernel, dim3(grid), dim3(NT), LDS_BYTES, stream, a);
#endif
}
```

```cpp
#include <hip/hip_runtime.h>
#include <cstdio>
#include <cstdint>

#ifndef MK_PER_PHASE
#define MK_PER_PHASE 0
#endif

#define LAS __attribute__((address_space(3)))
typedef unsigned short bf16;
typedef short bf16x8 __attribute__((ext_vector_type(8)));
typedef short bf16x4 __attribute__((ext_vector_type(4)));
typedef float f32x4 __attribute__((ext_vector_type(4)));
typedef float f32x2 __attribute__((ext_vector_type(2)));
typedef unsigned u32x4 __attribute__((ext_vector_type(4)));
typedef unsigned u32x2 __attribute__((ext_vector_type(2)));

typedef __bf16 hwbf16x2 __attribute__((ext_vector_type(2)));
__device__ __forceinline__ unsigned f2bf(float f) { return (unsigned)__builtin_bit_cast(unsigned short, (__bf16)f); }
__device__ __forceinline__ unsigned pk2(float lo, float hi) { const hwbf16x2 v = {(__bf16)lo, (__bf16)hi}; return __builtin_bit_cast(unsigned, v); }
__device__ __forceinline__ unsigned f2bf_sw(float f) { unsigned u = __builtin_bit_cast(unsigned, f); return (u + 0x7fffu + ((u >> 16) & 1u)) >> 16; }
__device__ __forceinline__ unsigned pk2_sw(float lo, float hi) { return f2bf_sw(lo) | (f2bf_sw(hi) << 16); }
__device__ __forceinline__ float bf2f(unsigned b) { return __builtin_bit_cast(float, b << 16); }
__device__ __forceinline__ float bflo(unsigned w) { return __builtin_bit_cast(float, w << 16); }
__device__ __forceinline__ float bfhi(unsigned w) { return __builtin_bit_cast(float, w & 0xffff0000u); }
__device__ __forceinline__ float fast_rcp(float x) { return __builtin_amdgcn_rcpf(x); }
__device__ __forceinline__ float silu_f(float a) { return a * fast_rcp(1.0f + __expf(-a)); }
__device__ __forceinline__ float wave_sum(float v) {
#pragma unroll
    for (int o = 1; o < 64; o <<= 1) v += __shfl_xor(v, o);
    return v;
}

constexpr int D = 1024, NCTX = 8192, NLAT = 2048, M = NCTX + NLAT, DFF = 2816, NMOD = 9216;
constexpr int GLA_NP = 3328, SSD_NP = 5376;

namespace pg8 {
constexpr int BM = 256, BK = 64, HALF = 128, HTB = HALF * BK * 2, STAGE_BYTES = 8 * HTB, NXCD = 8, WGM = 8;
__host__ __device__ __forceinline__ int lds_byte(int r, int c) { const int st = (r >> 4) * 2 + (c >> 5), rr = r & 15, cc = c & 31, ob = rr * 64 + cc * 2; return st * 1024 + (ob ^ (((ob >> 9) & 1) << 5)); }
__host__ __device__ __forceinline__ void stage_rc(int b, int& R, int& C) { const int st = b / 1024, sb = b % 1024, swz = sb ^ (((sb >> 9) & 1) << 5); R = (st >> 1) * 16 + swz / 64; C = (st & 1) * 32 + (swz % 64) / 2; }
__host__ __device__ __forceinline__ int perm32(int rho) { const int n = rho >> 4, i = rho & 15; return 8 * (i >> 2) + 4 * n + (i & 3); }
struct Unit { int pm, pn, nb, bsel; };
struct Gemm { const bf16* A; const bf16* Bt; int M, N, K; };
struct TileOrder {
    int nM, nN, nwg, G, c, nfull, R; bool halves, thin;
    __host__ __device__ __forceinline__ void init(int M_, int N_, int G_, int c_, bool half_ok, bool thin_ = false) { nM = M_ / BM; nN = N_ / BM; thin = thin_ && half_ok; if (thin) nN -= 1;
        nwg = nM * nN; G = G_; c = c_; nfull = nwg / G; R = nwg - nfull * G; halves = !thin && half_ok && R > 0 && 2 * R <= G; }
    __host__ __device__ __forceinline__ void decode(int L, Unit& u) const {
        int wgid = L; { const int q = nwg / NXCD, r = nwg % NXCD, xcd = wgid % NXCD, off = wgid / NXCD; wgid = (xcd < r ? xcd * (q + 1) : r * (q + 1) + (xcd - r) * q) + off; }
        const int nig = WGM * nN, gid = wgid / nig, fm = gid * WGM, gsz = (nM - fm) < WGM ? (nM - fm) : WGM;
        u.pm = fm + ((wgid % nig) % gsz); u.pn = (wgid % nig) / gsz;
    }
    __host__ __device__ __forceinline__ bool next(int i, Unit& u) const {
        if (i < nfull) { decode(i * G + c, u); u.nb = 2; u.bsel = 0; return true; }
        if (thin) { if (i == nfull && c < R) { decode(nfull * G + c, u); u.nb = 2; u.bsel = 0; return true; }
            if (c < R) return false;
            const int t = (c - R) + (i - nfull) * (G - R); if (t >= nM) return false;
            u.pm = t; u.pn = nN; u.nb = 1; u.bsel = 0; return true; }
        if (i > nfull) return false;
        if (halves) { if (c >= 2 * R) return false; decode(nfull * G + (c >> 1), u); u.nb = 1; u.bsel = c & 1; return true; }
        if (c >= R) return false;
        decode(nfull * G + c, u); u.nb = 2; u.bsel = 0; return true;
    }
    __device__ __forceinline__ void a_ready(const Unit&) const {}
    __device__ __forceinline__ void done(const Unit&) const {}
};
template <class Epi, class Sched>
__device__ __forceinline__ void gemm_phase(LAS unsigned char* lds, const Gemm g, const Sched& S, const Epi& E, const int tid) {
    const int wid = __builtin_amdgcn_readfirstlane(tid >> 6), lane = tid & 63, wr = wid >> 2, wc = wid & 3, fr = lane & 15, fq = lane >> 4;
    const int K = g.K, nt = K / BK;
    unsigned voffA[2], voffB[2];
#pragma unroll
    for (int i = 0; i < 2; ++i) { int R, C; stage_rc(tid * 16 + i * 8192, R, C); const int Rb = Epi::PERM ? ((R & ~31) + perm32(R & 31)) : R;
        voffA[i] = (unsigned)(R * K + C) * 2u; voffB[i] = (unsigned)(Rb * K + C) * 2u; }
    unsigned voffX[2] = {0u, 0u};
    if constexpr (Epi::XPF) { voffX[0] = (unsigned)(((wr * 64 + (lane >> 2)) * 1024 + wc * 32 + 8 * (lane & 3)) * 2); voffX[1] = voffX[0] + 256u; }
    const size_t kstep = (size_t)(BK * 2);
    const size_t hstep = (size_t)HALF * K * 2;
    const size_t tstep = 2 * hstep;
    const unsigned ldsw = (unsigned)wid * 1024u;
    const int aoff = lds_byte(wr * 64 + fr, fq * 8), boff = lds_byte(wc * 32 + fr, fq * 8);
#define PG8_SA(b, h) (((b) * 2 + (h)) * HTB)
#define PG8_SB(b, h) ((4 + (b) * 2 + (h)) * HTB)
#define PG8_STAGE(bufoff, gbase, voff) do { _Pragma("unroll") for (int _i = 0; _i < 2; ++_i) \
        __builtin_amdgcn_global_load_lds((const unsigned*)((const char*)(gbase) + (voff)[_i]), (LAS unsigned*)(lds + (bufoff) + ldsw + _i * 8192), 16, 0, 0); } while (0)
#define PG8_LDA(dst, b, h) do { _Pragma("unroll") for (int m = 0; m < 4; ++m) _Pragma("unroll") for (int k = 0; k < 2; ++k) dst[m][k] = *(const LAS bf16x8*)(lds + PG8_SA(b, h) + aoff + m * 2048 + k * 1024); } while (0)
#define PG8_LDB(dst, b, h) do { _Pragma("unroll") for (int n = 0; n < 2; ++n) _Pragma("unroll") for (int k = 0; k < 2; ++k) dst[n][k] = *(const LAS bf16x8*)(lds + PG8_SB(b, h) + boff + n * 2048 + k * 1024); } while (0)
#define PG8_MMA(ai, bj, At, Bt) do { __builtin_amdgcn_s_setprio(1); _Pragma("unroll") for (int m = 0; m < 4; ++m) _Pragma("unroll") for (int n = 0; n < 2; ++n) _Pragma("unroll") for (int k = 0; k < 2; ++k) \
        acc[ai][bj][m][n] = __builtin_amdgcn_mfma_f32_16x16x32_bf16(Bt[n][k], At[m][k], acc[ai][bj][m][n], 0, 0, 0); __builtin_amdgcn_s_setprio(0); } while (0)
#define PG8_WAIT_V(n) asm volatile("s_waitcnt vmcnt(" #n ")" ::: "memory")
#define PG8_WAIT_L(n) asm volatile("s_waitcnt lgkmcnt(" #n ")" ::: "memory")
#define PG8_BAR __builtin_amdgcn_s_barrier()
#define PG8_SCHED __builtin_amdgcn_sched_barrier(0)
    Unit cur, nxt; int ui = 0;
    if (!S.next(0, cur)) return;
    f32x4 acc[2][2][4][2];
#pragma unroll
    for (int a = 0; a < 2; ++a)
#pragma unroll
        for (int b = 0; b < 2; ++b)
#pragma unroll
            for (int m = 0; m < 4; ++m)
#pragma unroll
                for (int n = 0; n < 2; ++n) acc[a][b][m][n] = (f32x4){0.f, 0.f, 0.f, 0.f};
    bf16x8 At[4][2], B0[2][2], B1[2][2];
    const char* cA = (const char*)g.A + (size_t)cur.pm * tstep; const char* cB = (const char*)g.Bt + (size_t)cur.pn * tstep + (size_t)cur.bsel * hstep;
    size_t chB = cur.nb == 2 ? hstep : 0;
    S.a_ready(cur);
    unsigned vP1[2] = {chB == 0 ? 0u : voffB[0], chB == 0 ? 0u : voffB[1]};
    PG8_STAGE(PG8_SB(0, 0), cB, voffB); PG8_STAGE(PG8_SB(0, 1), cB + chB, vP1); PG8_STAGE(PG8_SA(0, 0), cA, voffA); PG8_STAGE(PG8_SA(0, 1), cA + hstep, voffA);
    if (wr == 1) PG8_BAR;
    PG8_WAIT_V(2); PG8_BAR;
    PG8_STAGE(PG8_SB(1, 0), cB + kstep, voffB); PG8_STAGE(PG8_SA(1, 0), cA + kstep, voffA); PG8_STAGE(PG8_SB(1, 1), cB + chB + kstep, vP1);
    PG8_WAIT_V(6); PG8_BAR;
    for (;;) {
        const bool has_next = S.next(ui + 1, nxt);
        const char* nA = has_next ? (const char*)g.A + (size_t)nxt.pm * tstep : cA; const char* nB = has_next ? (const char*)g.Bt + (size_t)nxt.pn * tstep + (size_t)nxt.bsel * hstep : cB;
        const size_t nhB = has_next ? (nxt.nb == 2 ? hstep : 0) : chB;
        const bool full = cur.nb == 2;
        for (int t = 0; t < nt; t += 2) {
            const bool last = (t == nt - 2);
            const char* a1 = cA + (size_t)(t + 1) * kstep;
            const char* a2 = last ? nA : cA + (size_t)(t + 2) * kstep; const char* b2 = last ? nB : cB + (size_t)(t + 2) * kstep;
            const char* a3 = a2 + kstep; const char* b3 = b2 + kstep;
            const size_t hb = last ? nhB : chB;
            if (last && has_next) S.a_ready(nxt);
            PG8_LDB(B0, 0, 0); if (full) PG8_LDB(B1, 0, 1); PG8_SCHED; PG8_LDA(At, 0, 0); PG8_STAGE(PG8_SA(1, 1), a1 + hstep, voffA);
            PG8_WAIT_V(8); PG8_WAIT_L(0); PG8_BAR; PG8_MMA(0, 0, At, B0); if (full) PG8_MMA(0, 1, At, B1); PG8_BAR; PG8_SCHED;
            const char* s4 = b2; const char* s5 = b2 + hb; const char* s0 = a2; const char* s1 = a2 + hstep; const char* s6 = b3; const char* s7 = b3 + hb; const char* s2 = a3;
            const bool dead = last && !has_next;
            unsigned vB[2] = {dead ? 0u : voffB[0], dead ? 0u : voffB[1]}, vA[2] = {dead ? 0u : voffA[0], dead ? 0u : voffA[1]};
            if constexpr (Epi::XPF) { if (last && !has_next && E.xpf_on()) { const char* xt = E.xtile(cur); constexpr size_t GR = 16 * 1024 * 2;
                s4 = xt; s5 = xt + GR; s0 = xt + 2 * GR; s1 = xt + 3 * GR; s6 = xt + 8 * GR; s7 = xt + 9 * GR; s2 = xt + 10 * GR;
                vB[0] = vA[0] = voffX[0]; vB[1] = vA[1] = voffX[1]; } }
            const unsigned vB1[2] = {hb == 0 ? 0u : vB[0], hb == 0 ? 0u : vB[1]};
            PG8_LDA(At, 0, 1); PG8_STAGE(PG8_SB(0, 0), s4, vB); PG8_STAGE(PG8_SB(0, 1), s5, vB1); PG8_STAGE(PG8_SA(0, 0), s0, vA);
            PG8_WAIT_V(8); PG8_WAIT_L(0); PG8_BAR; PG8_MMA(1, 0, At, B0); if (full) PG8_MMA(1, 1, At, B1); PG8_BAR; PG8_SCHED;
            PG8_LDB(B0, 1, 0); if (full) PG8_LDB(B1, 1, 1); PG8_SCHED; PG8_LDA(At, 1, 0); PG8_STAGE(PG8_SA(0, 1), s1, vA);
            PG8_WAIT_V(8); PG8_WAIT_L(0); PG8_BAR; PG8_MMA(0, 0, At, B0); if (full) PG8_MMA(0, 1, At, B1); PG8_BAR; PG8_SCHED;
            PG8_LDA(At, 1, 1); PG8_STAGE(PG8_SB(1, 0), s6, vB); PG8_STAGE(PG8_SB(1, 1), s7, vB1); PG8_STAGE(PG8_SA(1, 0), s2, vA);
            PG8_WAIT_V(8); PG8_WAIT_L(0); PG8_BAR; PG8_MMA(1, 0, At, B0); if (full) PG8_MMA(1, 1, At, B1); PG8_BAR; PG8_SCHED;
        }
        if (wr == 0) PG8_BAR;
        E(acc, cur, wr, wc, fr, fq); S.done(cur);
        if (!has_next) break;
#pragma unroll
        for (int a = 0; a < 2; ++a)
#pragma unroll
            for (int b = 0; b < 2; ++b)
#pragma unroll
                for (int m = 0; m < 4; ++m)
#pragma unroll
                    for (int n = 0; n < 2; ++n) acc[a][b][m][n] = (f32x4){0.f, 0.f, 0.f, 0.f};
        cur = nxt; cA = nA; cB = nB; chB = nhB; ++ui;
        if (wr == 1) PG8_BAR;
    }
    PG8_WAIT_V(0);
    PG8_BAR;
#undef PG8_SA
#undef PG8_SB
#undef PG8_STAGE
#undef PG8_LDA
#undef PG8_LDB
#undef PG8_MMA
#undef PG8_WAIT_V
#undef PG8_WAIT_L
#undef PG8_BAR
#undef PG8_SCHED
}
}

constexpr int SWN = 5632;
__device__ __forceinline__ float rstd_of(const float* ssq, int row) { return 1.0f / sqrtf(ssq[row] * (1.0f / 1024.0f) + 1e-6f); }
__device__ __forceinline__ int cond_of_row(int row) { return row < NCTX ? 0 : 1 + ((row - NCTX) >> 10); }

typedef const f32x4 (&AccRef)[2][2][4][2];
struct EpiSwiglu {
    static constexpr bool HALF_OK = true; static constexpr bool PERM = true; static constexpr bool XPF = false;
    bf16* H; const float* ssq; const float* sw; LAS unsigned char* lds;
    __device__ __forceinline__ void operator()(AccRef acc, const pg8::Unit& u, int wr, int wc, int fr, int fq) const {
        const int row0 = u.pm * 256 + wr * 64 + fr, h0 = u.pn * 128 + 64 * u.bsel + 16 * wc + 4 * fq;
        float rs[2][4];
#pragma unroll
        for (int ai = 0; ai < 2; ++ai)
#pragma unroll
            for (int m = 0; m < 4; ++m) rs[ai][m] = ssq[row0 + ai * 128 + m * 16];
        const float* swc = sw + (size_t)cond_of_row(u.pm * 256) * SWN + h0;
        f32x4 sa[2], su[2];
#pragma unroll
        for (int bj = 0; bj < 2; ++bj) { sa[bj] = *(const f32x4*)(swc + bj * 64); su[bj] = *(const f32x4*)(swc + DFF + bj * 64); }
        const int lane = fq * 16 + fr, r = lane >> 2, qd = lane & 3;
        LAS unsigned char* sc = lds + 131072 + (wr * 4 + wc) * 1024;
        LAS unsigned char* tw0 = sc + fr * 64 + (((fq >> 1)) ^ ((fr >> 1) & 3)) * 16 + (fq & 1) * 8;
        LAS unsigned char* tw1 = sc + fr * 64 + (((fq >> 1) + 2) ^ ((fr >> 1) & 3)) * 16 + (fq & 1) * 8;
        LAS unsigned char* trp = sc + r * 64 + (qd ^ ((r >> 1) & 3)) * 16;
        bf16* hp = H + (size_t)(u.pm * 256 + wr * 64 + r) * DFF + u.pn * 128 + 64 * u.bsel + 16 * wc + (qd >> 1) * 64 + (qd & 1) * 8;
        const bool st = (qd >> 1) < u.nb;
#define ES_TW(q_) do { const int ai = (q_) >> 2, m = (q_) & 3; const float r1 = 1.0f / sqrtf(rs[ai][m] * (1.0f / 1024.0f) + 1e-6f); \
            _Pragma("unroll") for (int bj = 0; bj < 2; ++bj) { if (bj >= u.nb) continue; const f32x4 a = acc[ai][bj][m][0] * r1 + sa[bj], g = acc[ai][bj][m][1] * r1 + su[bj]; \
                u32x2 w; w.x = pk2(silu_f(a[0]) * g[0], silu_f(a[1]) * g[1]); w.y = pk2(silu_f(a[2]) * g[2], silu_f(a[3]) * g[3]); \
                *(LAS u32x2*)(bj ? tw1 : tw0) = w; } } while (0)
        ES_TW(0);
#pragma unroll
        for (int q = 0; q < 8; ++q) {
            const u32x4 o = *(const LAS u32x4*)trp;
            if (q + 1 < 8) ES_TW(q + 1);
            if (st) *(u32x4*)(hp + (size_t)((q >> 2) * 128 + (q & 3) * 16) * DFF) = o;
        }
#undef ES_TW
    }
};
template <bool NEXT>
struct EpiResid {
    static constexpr bool HALF_OK = false; static constexpr bool PERM = true; static constexpr bool XPF = true;
    bf16* X; const float* gate;
    const float* gnext; const float* scnext; bf16* HS; float* ssqw; LAS unsigned char* lds; int ldsmode; float coef; float addss;
    __device__ __forceinline__ bool xpf_on() const { return ldsmode != 0; }
    __device__ __forceinline__ const char* xtile(const pg8::Unit& u) const { return (const char*)(X + (size_t)u.pm * 256 * D + u.pn * 256); }
    __device__ __forceinline__ void operator()(AccRef acc, const pg8::Unit& u, int wr, int wc, int fr, int fq) const {
        const int cond = cond_of_row(u.pm * 256);
        if (ldsmode) {
            const int lane = fq * 16 + fr, jr = lane >> 2, jp = lane & 3;
            LAS unsigned char* lw = lds + (wr * 4 + wc) * 1024;
            LAS unsigned char* rb = lw + lane * 16;
            LAS unsigned char* tr0 = lw + 3 * 16384 + (jr >> 3) * 8192 + ((jr & 7) * 8 + ((2 * jp) ^ (jr & 7))) * 16;
            LAS unsigned char* tr1 = lw + 3 * 16384 + (jr >> 3) * 8192 + ((jr & 7) * 8 + ((2 * jp + 1) ^ (jr & 7))) * 16;
            LAS unsigned char* tw0 = lw + 3 * 16384 + (fr >> 3) * 8192 + ((fr & 7) * 8 + ((2 * fq) ^ (fr & 7))) * 16;
            LAS unsigned char* tw1 = lw + 3 * 16384 + (fr >> 3) * 8192 + ((fr & 7) * 8 + ((2 * fq + 1) ^ (fr & 7))) * 16;
            const size_t so = (size_t)(u.pm * 256 + wr * 64 + jr) * D + u.pn * 256 + wc * 32 + 8 * jp;
            const int colS = u.pn * 256 + wc * 32 + 8 * jp;
            u32x4 x7[2];
#pragma unroll
            for (int bj = 0; bj < 2; ++bj) x7[bj] = *(const u32x4*)(X + so + (size_t)(128 + 48) * D + bj * 128);
            f32x4 gvS[2][2], gmS[2][2];
#pragma unroll
            for (int bj = 0; bj < 2; ++bj)
#pragma unroll
                for (int n = 0; n < 2; ++n) { gvS[bj][n] = *(const f32x4*)(gate + (size_t)cond * NMOD + colS + bj * 128 + n * 4) * coef;
                    if (NEXT) gmS[bj][n] = *(const f32x4*)(gnext + colS + bj * 128 + n * 4) * (*(const f32x4*)(scnext + (size_t)cond * NMOD + colS + bj * 128 + n * 4) + 1.0f);
                    else gmS[bj][n] = (f32x4){0.f, 0.f, 0.f, 0.f}; }
            f32x4 pv[2][2];
#define ER_XCH(q_, dst_) do { _Pragma("unroll") for (int bj = 0; bj < 2; ++bj) { *(LAS f32x4*)tw0 = acc[(q_) >> 2][bj][(q_) & 3][0]; *(LAS f32x4*)tw1 = acc[(q_) >> 2][bj][(q_) & 3][1]; \
                dst_[bj][0] = *(const LAS f32x4*)tr0; dst_[bj][1] = *(const LAS f32x4*)tr1; } } while (0)
            ER_XCH(0, pv);
#define ER_LGRP(q_, SLOT_, W_) { u32x4 xr[2]; f32x4 pn[2][2]; \
            if ((q_) < 7) { asm volatile("s_waitcnt vmcnt(" #W_ ")" ::: "memory"); \
                _Pragma("unroll") for (int bj = 0; bj < 2; ++bj) xr[bj] = *(const LAS u32x4*)(rb + (SLOT_) * 16384 + bj * 8192); } \
            else { xr[0] = x7[0]; xr[1] = x7[1]; } \
            if ((q_) + 1 < 8) ER_XCH((q_) + 1, pn); \
            const size_t ro = so + (size_t)(((q_) >> 2) * 128 + ((q_) & 3) * 16) * D; float ss = 0.f; \
            _Pragma("unroll") for (int bj = 0; bj < 2; ++bj) { \
                const f32x4 xa = {bflo(xr[bj].x), bfhi(xr[bj].x), bflo(xr[bj].y), bfhi(xr[bj].y)}, xb = {bflo(xr[bj].z), bfhi(xr[bj].z), bflo(xr[bj].w), bfhi(xr[bj].w)}; \
                const f32x4 x0 = xa + pv[bj][0] * gvS[bj][0], x1 = xb + pv[bj][1] * gvS[bj][1]; \
                u32x4 xo; xo.x = pk2(x0[0], x0[1]); xo.y = pk2(x0[2], x0[3]); xo.z = pk2(x1[0], x1[1]); xo.w = pk2(x1[2], x1[3]); *(u32x4*)(X + ro + bj * 128) = xo; \
                if (NEXT) { ss += ((x0[0] * x0[0] + x0[1] * x0[1]) + (x0[2] * x0[2] + x0[3] * x0[3])) + ((x1[0] * x1[0] + x1[1] * x1[1]) + (x1[2] * x1[2] + x1[3] * x1[3])); \
                    const f32x4 h0 = x0 * gmS[bj][0], h1 = x1 * gmS[bj][1]; \
                    u32x4 ho; ho.x = pk2(h0[0], h0[1]); ho.y = pk2(h0[2], h0[3]); ho.z = pk2(h1[0], h1[1]); ho.w = pk2(h1[2], h1[3]); *(u32x4*)(HS + ro + bj * 128) = ho; } } \
            if (NEXT) { ss += __shfl_xor(ss, 1); ss += __shfl_xor(ss, 2); \
                if (jp == 0) atomicAdd(ssqw + u.pm * 256 + wr * 64 + ((q_) >> 2) * 128 + ((q_) & 3) * 16 + jr, ss * addss); } \
            if ((q_) + 1 < 8) { _Pragma("unroll") for (int bj = 0; bj < 2; ++bj) { pv[bj][0] = pn[bj][0]; pv[bj][1] = pn[bj][1]; } } \
            __builtin_amdgcn_sched_barrier(0); }
            if (NEXT) { ER_LGRP(0, 4, 12) ER_LGRP(1, 5, 14) ER_LGRP(2, 0, 16) ER_LGRP(3, 1, 18) ER_LGRP(4, 6, 20) ER_LGRP(5, 7, 22) ER_LGRP(6, 2, 24) ER_LGRP(7, 0, 0) }
            else      { ER_LGRP(0, 4, 12) ER_LGRP(1, 5, 12) ER_LGRP(2, 0, 12) ER_LGRP(3, 1, 12) ER_LGRP(4, 6, 12) ER_LGRP(5, 7, 12) ER_LGRP(6, 2, 12) ER_LGRP(7, 0, 0) }
#undef ER_LGRP
#undef ER_XCH
        } else {
            const int row0 = u.pm * 256 + wr * 64 + fr, col0 = u.pn * 256 + wc * 32 + 8 * fq;
            f32x4 gv[2][2], gm[2][2];
#pragma unroll
            for (int bj = 0; bj < 2; ++bj)
#pragma unroll
                for (int n = 0; n < 2; ++n) { gv[bj][n] = *(const f32x4*)(gate + (size_t)cond * NMOD + col0 + bj * 128 + n * 4) * coef;
                    if (NEXT) gm[bj][n] = *(const f32x4*)(gnext + col0 + bj * 128 + n * 4) * (*(const f32x4*)(scnext + (size_t)cond * NMOD + col0 + bj * 128 + n * 4) + 1.0f);
                    else gm[bj][n] = (f32x4){0.f, 0.f, 0.f, 0.f}; }
#pragma unroll
            for (int q = 0; q < 8; ++q) { const int ai = q >> 2, m = q & 3, row = row0 + ai * 128 + m * 16; float ss = 0.f;
#pragma unroll
                for (int bj = 0; bj < 2; ++bj) { const u32x4 xr = *(const u32x4*)(X + (size_t)row * D + col0 + bj * 128);
                    const f32x4 xa = {bflo(xr.x), bfhi(xr.x), bflo(xr.y), bfhi(xr.y)}, xb = {bflo(xr.z), bfhi(xr.z), bflo(xr.w), bfhi(xr.w)};
                    const f32x4 x0 = xa + acc[ai][bj][m][0] * gv[bj][0], x1 = xb + acc[ai][bj][m][1] * gv[bj][1];
                    u32x4 xo; xo.x = pk2(x0[0], x0[1]); xo.y = pk2(x0[2], x0[3]); xo.z = pk2(x1[0], x1[1]); xo.w = pk2(x1[2], x1[3]); *(u32x4*)(X + (size_t)row * D + col0 + bj * 128) = xo;
                    if (NEXT) { ss += ((x0[0] * x0[0] + x0[1] * x0[1]) + (x0[2] * x0[2] + x0[3] * x0[3])) + ((x1[0] * x1[0] + x1[1] * x1[1]) + (x1[2] * x1[2] + x1[3] * x1[3]));
                        const f32x4 h0 = x0 * gm[bj][0], h1 = x1 * gm[bj][1];
                        u32x4 ho; ho.x = pk2(h0[0], h0[1]); ho.y = pk2(h0[2], h0[3]); ho.z = pk2(h1[0], h1[1]); ho.w = pk2(h1[2], h1[3]); *(u32x4*)(HS + (size_t)row * D + col0 + bj * 128) = ho; } }
                if (NEXT) { ss += __shfl_xor(ss, 16); ss += __shfl_xor(ss, 32); if (fq == 0) atomicAdd(ssqw + row, ss * addss); } }
        }
    }
};
struct EpiF32 {
    static constexpr bool HALF_OK = true; static constexpr bool PERM = false; static constexpr bool XPF = false;
    float* C; int ldc;
    __device__ __forceinline__ void operator()(AccRef acc, const pg8::Unit& u, int wr, int wc, int fr, int fq) const {
        const int row0 = u.pm * 256 + wr * 64 + fr, col0 = u.pn * 256 + 128 * u.bsel + wc * 32 + 4 * fq;
#pragma unroll
        for (int ai = 0; ai < 2; ++ai)
#pragma unroll
            for (int m = 0; m < 4; ++m) { float* rowp = C + (size_t)(row0 + ai * 128 + m * 16) * ldc + col0;
#pragma unroll
                for (int bj = 0; bj < 2; ++bj)
#pragma unroll
                    for (int n = 0; n < 2; ++n) { if (bj < u.nb) *(f32x4*)(rowp + bj * 128 + n * 16) = acc[ai][bj][m][n]; } }
    }
};

struct EpiBf16Plain {
    static constexpr bool HALF_OK = true; static constexpr bool PERM = false; static constexpr bool XPF = false;
    bf16* C; int ldc; const float* ssq; const float* sw;
    __device__ __forceinline__ void operator()(AccRef acc, const pg8::Unit& u, int wr, int wc, int fr, int fq) const {
        const int row0 = u.pm * 256 + wr * 64 + fr, col0 = u.pn * 256 + 128 * u.bsel + wc * 32 + 4 * fq;
        float rs[2][4];
#pragma unroll
        for (int ai = 0; ai < 2; ++ai)
#pragma unroll
            for (int m = 0; m < 4; ++m) rs[ai][m] = ssq[row0 + ai * 128 + m * 16];
        const float* swc = sw + (size_t)cond_of_row(u.pm * 256) * SWN + col0;
        f32x4 sv[2][2];
#pragma unroll
        for (int bj = 0; bj < 2; ++bj)
#pragma unroll
            for (int n = 0; n < 2; ++n) sv[bj][n] = *(const f32x4*)(swc + bj * 128 + n * 16);
#pragma unroll
        for (int ai = 0; ai < 2; ++ai)
#pragma unroll
            for (int m = 0; m < 4; ++m) { bf16* rowp = C + (size_t)(row0 + ai * 128 + m * 16) * ldc + col0; const float r1 = 1.0f / sqrtf(rs[ai][m] * (1.0f / 1024.0f) + 1e-6f);
#pragma unroll
                for (int bj = 0; bj < 2; ++bj)
#pragma unroll
                    for (int n = 0; n < 2; ++n) { if (bj >= u.nb) continue; const f32x4 v = acc[ai][bj][m][n] * r1 + sv[bj][n]; u32x2 o; o.x = pk2(v[0], v[1]); o.y = pk2(v[2], v[3]); *(u32x2*)(rowp + bj * 128 + n * 16) = o; } }
    }
};

#define XB_TMO      128
#define XB_XCNT(j)  (256  + 64 * (j))
#define XB_XSUB(j)  (1280 + 64 * (j))
#define XB_XGEN(j)  (2304 + 64 * (j))
#define XB_TOP      3328
#define XB_TOPGEN   3392
#define XCD_BAR_WORDS 3456
#define XB_SPIN_CAP (1u << 20)
__device__ __forceinline__ unsigned xb_ld(unsigned* p)              { return __hip_atomic_load(p, __ATOMIC_RELAXED, __HIP_MEMORY_SCOPE_AGENT); }
__device__ __forceinline__ unsigned xb_add(unsigned* p, unsigned v) { return __hip_atomic_fetch_add(p, v, __ATOMIC_RELAXED, __HIP_MEMORY_SCOPE_AGENT); }
__device__ __forceinline__ unsigned xb_xcc_id() { return (unsigned)__builtin_amdgcn_s_getreg((3 << 11) | 20) & 0xFu; }
#define XB_SPIN(cond, bar) do { unsigned _sp = 0; while (cond) { __builtin_amdgcn_s_sleep(1); \
    if ((++_sp & 255u) == 0u) { if (xb_ld(&(bar)[XB_TMO])) break; if (_sp > XB_SPIN_CAP) { atomicAdd(&(bar)[XB_TMO], 1u); break; } } } } while (0)
struct XcdBarrier { unsigned* bar; unsigned x; volatile LAS unsigned* st; };
__device__ __forceinline__ XcdBarrier xcd_barrier_post(unsigned* bar, volatile LAS unsigned* st) {
    XcdBarrier b; b.bar = bar; b.x = xb_xcc_id(); b.st = st;
    if (threadIdx.x == 0) (void)xb_add(&bar[XB_XCNT(b.x)], 1u);
    return b;
}
__device__ __forceinline__ void xcd_barrier_complete(unsigned* bar, unsigned x, unsigned& nloc, unsigned& nx) {
    const unsigned G = gridDim.x * gridDim.y * gridDim.z;
    unsigned sum, cnt, mine, sp = 0u;
    for (;;) {
        sum = 0u; cnt = 0u; mine = 0u;
#pragma unroll
        for (unsigned j = 0; j < 16; ++j) { const unsigned c = xb_ld(&bar[XB_XCNT(j)]); sum += c; cnt += (c > 0u) ? 1u : 0u; mine = (j == x) ? c : mine; }
        if (sum == G) break;
        __builtin_amdgcn_s_sleep(1);
        if ((++sp & 255u) == 0u) { if (xb_ld(&bar[XB_TMO])) break; if (sp > XB_SPIN_CAP) { atomicAdd(&bar[XB_TMO], 1u); break; } }
    }
    nloc = mine > 0u ? mine : 1u; nx = cnt > 0u ? cnt : 1u;
}
__device__ __forceinline__ void xcd_barrier(const XcdBarrier& b) {
    asm volatile("s_waitcnt vmcnt(0)" ::: "memory");
    __syncthreads();
    if (threadIdx.x == 0) {
        unsigned* bar = b.bar;
        __builtin_amdgcn_s_waitcnt(0);
        unsigned nloc = b.st[0], nx = b.st[1];
        if (nloc == 0u) { xcd_barrier_complete(bar, b.x, nloc, nx); b.st[0] = nloc; b.st[1] = nx; }
        const unsigned old = xb_add(&bar[XB_XSUB(b.x)], 1u);
        const unsigned gen = old / nloc;
        if (old + 1u == (gen + 1u) * nloc) {
            __builtin_amdgcn_fence(__ATOMIC_RELEASE, "agent");
            asm volatile("s_waitcnt vmcnt(0)" ::: "memory");
            const unsigned og = xb_add(&bar[XB_TOP], 1u);
            const unsigned tg = og / nx;
            if (og + 1u == (tg + 1u) * nx) xb_add(&bar[XB_TOPGEN], 1u);
            else XB_SPIN(xb_ld(&bar[XB_TOPGEN]) == tg, bar);
            __builtin_amdgcn_fence(__ATOMIC_ACQUIRE, "agent");
            xb_add(&bar[XB_XGEN(b.x)], 1u);
            asm volatile("s_waitcnt vmcnt(0)" ::: "memory");
        } else {
            XB_SPIN(xb_ld(&bar[XB_XGEN(b.x)]) == gen, bar);
            __builtin_amdgcn_fence(__ATOMIC_ACQUIRE, "agent");
            asm volatile("s_waitcnt vmcnt(0)" ::: "memory");
        }
    }
    __syncthreads();
}

constexpr size_t MiB = 1u << 20;
constexpr size_t WS_CTL = 0;
constexpr size_t WS_MOD = 1 * MiB;
constexpr size_t WS_ROPE = 2 * MiB;
constexpr size_t WS_CK = 3 * MiB;
constexpr size_t WS_CVT = 4 * MiB;
constexpr size_t WS_SW = 5 * MiB;
constexpr size_t WS_WFI = 6 * MiB;
constexpr size_t WS_WFO = WS_WFI + 8ull * 5632 * 1024 * 2;
constexpr size_t WS_WGI = WS_WFO + 8ull * 1024 * 2816 * 2;
constexpr size_t WS_WGO = WS_WGI + (size_t)GLA_NP * 1024 * 2;
constexpr size_t WS_WNI = WS_WGO + 1024ull * 1024 * 2;
constexpr size_t WS_WNO = WS_WNI + 3072ull * 1024 * 2;
constexpr size_t WS_WMI = WS_WNO + 1024ull * 1024 * 2;
constexpr size_t WS_WMO = WS_WMI + 2048ull * 1024 * 2;
constexpr size_t WS_WSI = WS_WMO + 1024ull * 1024 * 2;
constexpr size_t WS_WSO = WS_WSI + (size_t)SSD_NP * 1024 * 2;
constexpr size_t WS_WEND = WS_WSO + 1024ull * 2048 * 2;
constexpr size_t WS_X = 190 * MiB;
constexpr size_t WS_H = 230 * MiB;
constexpr size_t WS_HID = 250 * MiB;
constexpr size_t WS_R = 306 * MiB;
static_assert(WS_WEND <= WS_X && WS_X + (size_t)M * D * 4 <= WS_H && WS_H + (size_t)M * D * 2 <= WS_HID && WS_HID + (size_t)M * DFF * 2 <= WS_R, "ws map");
constexpr size_t WS_SLAB = 604 * MiB;
constexpr size_t WS_END = 668 * MiB;

constexpr int CW_BAR = 4096, CW_SKTMO = 8192, CW_SK = 16384;
constexpr size_t CTL_ZERO_BYTES = 32768;

constexpr int RING_BYTES = 131072, LDS_BYTES = 147456, LDSCTL_OFF = LDS_BYTES - 512, MISC_OFF = LDSCTL_OFF + 320;
constexpr int NWAVES = 8, NT = 512;

struct Args { const float* in[37]; float* out; unsigned char* ws; int ph_lo, ph_hi; };

struct Frame {
    LAS unsigned char* lds;
    int tid, lane, wave, G, bid;
    const float* const* in; float* out; unsigned char* ws;
};

template <int MAP, bool SWACC>
__device__ __forceinline__ void p0_transpose_item(const float* W, int K, int N, bf16* WT, int row_off, LAS float* scr, int item, int lane, const float* shift, float* sw) {
    const int nblk = N / 32, kb = item / nblk, nb = item % nblk, k0 = 64 * kb, n0 = 32 * nb;
    f32x4 ld[8];
#pragma unroll
    for (int i = 0; i < 8; ++i) ld[i] = __builtin_nontemporal_load((const f32x4*)(W + (size_t)(k0 + 8 * i + (lane >> 3)) * N + n0 + (lane & 7) * 4));
#pragma unroll
    for (int i = 0; i < 8; ++i) { LAS float* d = scr + (8 * i + (lane >> 3)) * 33 + (lane & 7) * 4; d[0] = ld[i][0]; d[1] = ld[i][1]; d[2] = ld[i][2]; d[3] = ld[i][3]; }
    if (SWACC) {
        f32x4 p0 = {0.f, 0.f, 0.f, 0.f}, p1 = p0, p2 = p0;
#pragma unroll
        for (int i = 0; i < 8; ++i) { const int kk = k0 + 8 * i + (lane >> 3); p0 += ld[i] * shift[kk]; p1 += ld[i] * shift[NMOD + kk]; p2 += ld[i] * shift[2 * NMOD + kk]; }
        float r0 = p0[0], r1 = p0[1], r2 = p0[2], r3 = p0[3], r4 = p1[0], r5 = p1[1], r6 = p1[2], r7 = p1[3], r8 = p2[0], r9 = p2[1], r10 = p2[2], r11 = p2[3];
#define RED3(x) x += __shfl_xor(x, 8); x += __shfl_xor(x, 16); x += __shfl_xor(x, 32);
        RED3(r0) RED3(r1) RED3(r2) RED3(r3) RED3(r4) RED3(r5) RED3(r6) RED3(r7) RED3(r8) RED3(r9) RED3(r10) RED3(r11)
#undef RED3
        if ((lane >> 3) == 0) { float* d = sw + n0 + (lane & 7) * 4;
            atomicAdd(d + 0, r0); atomicAdd(d + 1, r1); atomicAdd(d + 2, r2); atomicAdd(d + 3, r3);
            atomicAdd(d + SWN + 0, r4); atomicAdd(d + SWN + 1, r5); atomicAdd(d + SWN + 2, r6); atomicAdd(d + SWN + 3, r7);
            atomicAdd(d + 2 * SWN + 0, r8); atomicAdd(d + 2 * SWN + 1, r9); atomicAdd(d + 2 * SWN + 2, r10); atomicAdd(d + 2 * SWN + 3, r11); }
    }
    asm volatile("s_waitcnt lgkmcnt(0)" ::: "memory");
    const int c = lane & 7;
#pragma unroll
    for (int j = 0; j < 4; ++j) { const int n = (lane >> 3) + 8 * j; const LAS float* s = scr + (8 * c) * 33 + n;
        u32x4 o; o.x = pk2(s[0 * 33], s[1 * 33]); o.y = pk2(s[2 * 33], s[3 * 33]); o.z = pk2(s[4 * 33], s[5 * 33]); o.w = pk2(s[6 * 33], s[7 * 33]);
        int nn = n0 + n, dr;
        if (MAP == 1) { const int which = nn >= DFF ? 1 : 0, jj = nn - which * DFF; dr = 8 * (jj >> 2) + 4 * which + (jj & 3); } else dr = row_off + nn;
        *(u32x4*)(WT + (size_t)dr * K + k0 + 8 * c) = o; }
    asm volatile("s_waitcnt lgkmcnt(0)" ::: "memory");
}

template <int MAP, bool SWACC>
__device__ __forceinline__ void conv_mat(Frame& F, const float* W, int K, int N, bf16* WT, int gw, int NGW, const float* shift, float* sw) {
    LAS float* scr = (LAS float*)(F.lds + 16384 + F.wave * 12288);
    const int nitems = (K / 64) * (N / 32);
    for (int it = gw; it < nitems; it += NGW) p0_transpose_item<MAP, SWACC>(W, K, N, WT, 0, scr, it, F.lane, shift, sw);
}
__device__ __forceinline__ void mod_layers(Frame& F, int l_lo, int l_hi, int widx, int nw);
template <int GRP>
__device__ __forceinline__ void conv_group(Frame& F, int gw, int NGW) {
    const float* const* in = F.in; unsigned char* ws = F.ws;
    const float* MODp = (const float*)(ws + WS_MOD); float* SWp = (float*)(ws + WS_SW);
#define CV_FI(w) conv_mat<1, true>(F, in[11] + (size_t)(w) * 1024 * 5632, 1024, 5632, (bf16*)(ws + WS_WFI) + (size_t)(w) * 5632 * 1024, gw, NGW, MODp + (size_t)((w) / 2) * 3 * NMOD + (size_t)(3 * (((w) % 2) * 2)) * D, SWp + (size_t)(w) * 3 * SWN)
#define CV_FO(w) conv_mat<0, false>(F, in[12] + (size_t)(w) * 2816 * 1024, 2816, 1024, (bf16*)(ws + WS_WFO) + (size_t)(w) * 1024 * 2816, gw, NGW, nullptr, nullptr)
#define CV_MIXIN(idx, NN, dst, l, j) conv_mat<0, true>(F, in[idx], 1024, NN, (bf16*)(ws + dst), gw, NGW, MODp + (size_t)(l) * 3 * NMOD + 3 * D, SWp + (size_t)(j) * 3 * SWN)
#define CV_OUT(idx, KK, dst) conv_mat<0, false>(F, in[idx], KK, 1024, (bf16*)(ws + dst), gw, NGW, nullptr, nullptr)
    if constexpr (GRP == 0) { CV_FI(0); CV_FO(0);
        for (int bh = 0; bh < 32; ++bh) conv_mat<0, false>(F, in[4] + (size_t)bh * 256 * 64, 256, 64, (bf16*)(ws + WS_CVT) + (size_t)bh * 64 * 256, gw, NGW, nullptr, nullptr); }
    if constexpr (GRP == 1) { mod_layers(F, 1, 2, gw / NWAVES, NGW / NWAVES); CV_MIXIN(13, 3072, WS_WGI, 0, 8); CV_OUT(18, 1024, WS_WGO); CV_FI(1); CV_FO(1); }
    if constexpr (GRP == 2) { CV_FI(2); CV_FO(2); }
    if constexpr (GRP == 3) { mod_layers(F, 2, 3, gw / NWAVES, NGW / NWAVES); CV_MIXIN(19, 3072, WS_WNI, 1, 9); CV_OUT(21, 1024, WS_WNO); CV_FI(3); CV_FO(3); }
    if constexpr (GRP == 4) { mod_layers(F, 3, 4, gw / NWAVES, NGW / NWAVES); CV_FI(4); CV_FO(4); CV_MIXIN(22, 2048, WS_WMI, 2, 10); CV_OUT(27, 1024, WS_WMO); }
    if constexpr (GRP == 5) { CV_FI(5); }
    if constexpr (GRP == 6) { CV_FO(5); CV_FI(6); CV_FO(6); }
    if constexpr (GRP == 7) { CV_MIXIN(28, 5184, WS_WSI, 3, 11); CV_OUT(35, 2048, WS_WSO); }
    if constexpr (GRP == 8) { CV_FI(7); }
    if constexpr (GRP == 9) { CV_FO(7); }
#undef CV_FI
#undef CV_FO
#undef CV_MIXIN
#undef CV_OUT
}
__device__ __forceinline__ void mod_layers(Frame& F, int l_lo, int l_hi, int widx, int nw) {
    const float* const* in = F.in;
    LAS float* sc = (LAS float*)F.lds;
    LAS float* red = sc + 3 * 1024;
    __syncthreads();
    for (int i = F.tid; i < 3 * 1024; i += NT) { const int c = i >> 10, k = i & 1023; const float v = c == 0 ? in[7][k] : in[6][(c - 1) * 1024 + k]; sc[i] = v / (1.0f + expf(-v)); }
    __syncthreads();
    float* MOD = (float*)(F.ws + WS_MOD);
    const int kq = F.lane >> 3, c4 = (F.lane & 7) * 4;
    for (int item = l_lo * 288 + widx; item < l_hi * 288; item += nw) { const int l = item / 288, cb = item % 288;
        const float* W = in[9] + (size_t)l * 1024 * NMOD + cb * 32 + c4;
        f32x4 a0 = {0, 0, 0, 0}, a1 = a0, a2 = a0;
        const int kbeg = F.wave * 128 + kq;
        f32x4 w[16];
#pragma unroll
        for (int j = 0; j < 16; ++j) w[j] = __builtin_nontemporal_load((const f32x4*)(W + (size_t)(kbeg + 8 * j) * NMOD));
#pragma unroll
        for (int j = 0; j < 16; ++j) { const int k = kbeg + 8 * j; a0 += w[j] * sc[k]; a1 += w[j] * sc[1024 + k]; a2 += w[j] * sc[2048 + k]; }
#pragma unroll
        for (int e = 0; e < 4; ++e) {
#pragma unroll
            for (int o = 8; o < 64; o <<= 1) { a0[e] += __shfl_xor(a0[e], o); a1[e] += __shfl_xor(a1[e], o); a2[e] += __shfl_xor(a2[e], o); } }
        if (kq == 0) { *(LAS f32x4*)(red + (F.wave * 3 + 0) * 32 + c4) = a0; *(LAS f32x4*)(red + (F.wave * 3 + 1) * 32 + c4) = a1; *(LAS f32x4*)(red + (F.wave * 3 + 2) * 32 + c4) = a2; }
        __syncthreads();
        if (F.tid < 96) { const int c = F.tid >> 5, n = F.tid & 31; float s2 = in[10][l * NMOD + cb * 32 + n];
#pragma unroll
            for (int w8 = 0; w8 < 8; ++w8) s2 += red[(w8 * 3 + c) * 32 + n];
            MOD[(size_t)(l * 3 + c) * NMOD + cb * 32 + n] = s2; }
        __syncthreads();
    }
}
__device__ __forceinline__ void p0_phase(Frame& F) {
    const float* const* in = F.in; unsigned char* ws = F.ws;
    { const f32x4 z = {0.f, 0.f, 0.f, 0.f}; f32x4* swz = (f32x4*)(ws + WS_SW); f32x4* lnz = (f32x4*)(ws + WS_CTL + 640 * 1024);
      for (int i = F.bid * NT + F.tid; i < 12 * 3 * SWN / 4; i += F.G * NT) swz[i] = z;
      for (int i = F.bid * NT + F.tid; i < 32768 / 4; i += F.G * NT) lnz[i] = z; }
    mod_layers(F, 0, 1, F.bid, F.G);
    { float* RC = (float*)(ws + WS_ROPE); float* RS = RC + 65536;
      for (int i = F.bid * NT + F.tid; i < 65536; i += F.G * NT) { const int t = i >> 6, j = i & 63, hs = j >> 5, fi = j & 31;
          const float inv = powf(10000.0f, -(float)(2 * fi) / 64.0f); const float pos = (float)(hs == 0 ? (t >> 6) : (t & 63)); const float ang = pos * inv;
          RC[i] = cosf(ang); RS[i] = sinf(ang); } }
    { bf16* WGI = (bf16*)(ws + WS_WGI);
      for (int i = F.bid * NT + F.tid; i < 256 * 1024; i += F.G * NT) { const int r = i >> 10, d = i & 1023;
          float v = 0.f; if (r < 32) { const int e = r >> 4, rr = r & 15; v = in[14][((size_t)e * 1024 + d) * 16 + rr]; }
          WGI[(size_t)(3072 + r) * 1024 + d] = (bf16)f2bf(v); }
      bf16* WSI = (bf16*)(ws + WS_WSI);
      for (int i = F.bid * NT + F.tid; i < 192 * 1024; i += F.G * NT) WSI[(size_t)5184 * 1024 + i] = 0; }
    { bf16* CK = (bf16*)(ws + WS_CK);
      for (int i = F.bid * NT + F.tid; i < 2 * 16 * 256 * 64 / 4; i += F.G * NT) { const f32x4 v = *(const f32x4*)(in[3] + (size_t)i * 4); u32x2 o; o.x = pk2(v[0], v[1]); o.y = pk2(v[2], v[3]); *(u32x2*)(CK + (size_t)i * 4) = o; } }
}

__device__ __forceinline__ void first_norm_phase(Frame& F, const float* xp, const float* xs, bf16* X, const float* g, const float* mod  , bf16* HS, float* SSQ) {
    const int gw = F.bid * NWAVES + F.wave, NGW = F.G * NWAVES;
    constexpr int RB = 5;
    f32x4 gg[4];
#pragma unroll
    for (int j = 0; j < 4; ++j) gg[j] = *(const f32x4*)(g + 4 * F.lane + 256 * j);
    for (int base = gw; base < M; base += RB * NGW) {
        f32x4 v[RB][4];
#pragma unroll
        for (int k = 0; k < RB; ++k) { const int row = base + k * NGW, rc = row < M ? row : gw;
            const float* xr = rc < NCTX ? xp + (size_t)rc * D : xs + (size_t)(rc - NCTX) * D;
#pragma unroll
            for (int j = 0; j < 4; ++j) v[k][j] = __builtin_nontemporal_load((const f32x4*)(xr + 4 * F.lane + 256 * j)); }
#pragma unroll
        for (int k = 0; k < RB; ++k) { const int row = base + k * NGW; float s = 0.f;
#pragma unroll
            for (int j = 0; j < 4; ++j) s += (v[k][j][0] * v[k][j][0] + v[k][j][1] * v[k][j][1]) + (v[k][j][2] * v[k][j][2] + v[k][j][3] * v[k][j][3]);
            s = wave_sum(s);
            if (row < M) { const float* md = mod + (size_t)cond_of_row(row) * NMOD;
                if (F.lane == 0) SSQ[row] = s;
#pragma unroll
                for (int j = 0; j < 4; ++j) { const int c = 4 * F.lane + 256 * j;
                    { u32x2 xo; xo.x = pk2(v[k][j][0], v[k][j][1]); xo.y = pk2(v[k][j][2], v[k][j][3]); *(u32x2*)(X + (size_t)row * D + c) = xo; }
                    const f32x4 y = v[k][j] * gg[j] * (*(const f32x4*)(md + c) + 1.0f);
                    u32x2 o; o.x = pk2(y[0], y[1]); o.y = pk2(y[2], y[3]); *(u32x2*)(HS + (size_t)row * D + c) = o; } } }
    }
    { const float* const* in = F.in; const float* sh = (const float*)(F.ws + WS_MOD) + 3 * D; float* swg = (float*)(F.ws + WS_SW) + (size_t)8 * 3 * SWN;
      for (int o = gw; o < 96; o += NGW) { const int cond = o >> 5, r = o & 31, e = r >> 4, rr = r & 15; float a = 0.f;
          for (int d = F.lane; d < 1024; d += 64) a += sh[(size_t)cond * NMOD + d] * in[14][((size_t)e * 1024 + d) * 16 + rr];
          a = wave_sum(a); if (F.lane == 0) swg[(size_t)cond * SWN + 3072 + r] = a; } }
    conv_group<0>(F, gw, NGW);
}
__device__ __forceinline__ void final_norm_phase(Frame& F, const bf16* X, const float* g, float* out) {
    const int gw = F.bid * NWAVES + F.wave, NGW = F.G * NWAVES;
    constexpr int RB = 5;
    f32x4 gg[4];
#pragma unroll
    for (int j = 0; j < 4; ++j) gg[j] = *(const f32x4*)(g + 4 * F.lane + 256 * j);
    for (int base = gw; base < M; base += RB * NGW) {
        f32x4 v[RB][4];
#pragma unroll
        for (int k = 0; k < RB; ++k) { const int row = base + k * NGW, rc = row < M ? row : gw;
#pragma unroll
            for (int j = 0; j < 4; ++j) { const u32x2 xr = *(const u32x2*)(X + (size_t)rc * D + 4 * F.lane + 256 * j); v[k][j] = (f32x4){bflo(xr.x), bfhi(xr.x), bflo(xr.y), bfhi(xr.y)}; } }
#pragma unroll
        for (int k = 0; k < RB; ++k) { const int row = base + k * NGW; float s = 0.f;
#pragma unroll
            for (int j = 0; j < 4; ++j) s += (v[k][j][0] * v[k][j][0] + v[k][j][1] * v[k][j][1]) + (v[k][j][2] * v[k][j][2] + v[k][j][3] * v[k][j][3]);
            const float rstd = 1.0f / sqrtf(wave_sum(s) * (1.0f / D) + 1e-6f);
            if (row < M) {
#pragma unroll
                for (int j = 0; j < 4; ++j) *(f32x4*)(out + (size_t)row * D + 4 * F.lane + 256 * j) = v[k][j] * rstd * gg[j]; } }
    }
}


__device__ __forceinline__ unsigned pk4lo(const f32x4 v) { return pk2(v[0], v[1]); }
__device__ __forceinline__ unsigned pk4hi(const f32x4 v) { return pk2(v[2], v[3]); }
constexpr size_t GLA_UNIT_BYTES = 16384 * 3 + 512;
__device__ __forceinline__ void gla_prep_phase(Frame& F, const bf16* PROJ, unsigned char* GP, const float* w_a2, const float* b_a, const float* RC, const float* RS) {
    constexpr int S2 = 72;
    LAS float* z1s = (LAS float*)F.lds;
    LAS float* tot4 = z1s + 1024;
    LAS bf16* khT = (LAS bf16*)(tot4 + 512);
    const int tid = F.tid, d = tid & 127, qt = tid >> 7;
    const float qscale = 0.08838834764831845f;
    for (int u = F.bid; u < 160 * 8; u += F.G) { const int dir = u & 1, h = (u >> 1) & 3, ch = u >> 3, row0 = ch * 64;
        float w2[16];
#pragma unroll
        for (int rr = 0; rr < 16; ++rr) w2[rr] = w_a2[(size_t)(dir * 16 + rr) * 512 + h * 128 + d];
        const float bad = b_a[dir * 512 + h * 128 + d];
        float z1v[2];
#pragma unroll
        for (int e = 0; e < 2; ++e) { const int idx = tid + 512 * e; z1v[e] = bf2f(PROJ[(size_t)(row0 + (idx >> 4)) * GLA_NP + 3072 + dir * 16 + (idx & 15)]); }
        float qv[16], kv[16];
#pragma unroll
        for (int e = 0; e < 16; ++e) { const size_t rb = (size_t)(row0 + 16 * qt + e) * GLA_NP; qv[e] = bf2f(PROJ[rb + h * 128 + d]); kv[e] = bf2f(PROJ[rb + 512 + h * 128 + d]); }
        if (row0 >= NCTX) {
            const int hs = d >> 6, dd = d & 63, fi = dd & 31, pd = dd < 32 ? d + 32 : d - 32;
#pragma unroll
            for (int e = 0; e < 16; ++e) { const int row = row0 + 16 * qt + e, t = (row - NCTX) & 1023; const size_t rb = (size_t)row * GLA_NP;
                const float cs = RC[t * 64 + hs * 32 + fi], sn = RS[t * 64 + hs * 32 + fi], q2 = bf2f(PROJ[rb + h * 128 + pd]), k2 = bf2f(PROJ[rb + 512 + h * 128 + pd]);
                if (dd < 32) { qv[e] = qv[e] * cs - q2 * sn; kv[e] = kv[e] * cs - k2 * sn; } else { qv[e] = q2 * sn + qv[e] * cs; kv[e] = k2 * sn + kv[e] * cs; } }
        }
        __syncthreads();
#pragma unroll
        for (int e = 0; e < 2; ++e) z1s[tid + 512 * e] = z1v[e];
        __syncthreads();
        float P[16];
#pragma unroll
        for (int e = 0; e < 16; ++e) { const LAS f32x4* zp = (const LAS f32x4*)(z1s + (16 * qt + e) * 16); float z = bad;
#pragma unroll
            for (int r4 = 0; r4 < 4; ++r4) { const f32x4 x = zp[r4]; z += (x[0] * w2[4 * r4] + x[1] * w2[4 * r4 + 1]) + (x[2] * w2[4 * r4 + 2] + x[3] * w2[4 * r4 + 3]); }
            P[e] = (fminf(z, 0.f) - __logf(1.0f + __expf(-fabsf(z)))) * (1.0f / 16.0f); }
        if (dir == 0) {
#pragma unroll
            for (int e = 1; e < 16; ++e) P[e] += P[e - 1];
        } else {
#pragma unroll
            for (int e = 14; e >= 0; --e) P[e] += P[e + 1];
        }
        tot4[qt * 128 + d] = dir == 0 ? P[15] : P[0];
        __syncthreads();
        const float t0 = tot4[d], t1 = tot4[128 + d], t2 = tot4[256 + d], t3 = tot4[384 + d]; const float total = (t0 + t1) + (t2 + t3);
        float off;
        if (dir == 0) off = qt == 0 ? 0.f : (qt == 1 ? t0 : (qt == 2 ? t0 + t1 : t0 + t1 + t2));
        else off = qt == 3 ? 0.f : (qt == 2 ? t3 : (qt == 1 ? t3 + t2 : t3 + t2 + t1));
        unsigned char* ub = GP + (size_t)u * GLA_UNIT_BYTES;
        bf16* Qo = (bf16*)ub; bf16* Ko = Qo + 8192; bf16* KHo = Ko + 8192; float* GDo = (float*)(ub + 49152);
        if (qt == 0) GDo[d] = __expf(total);
#pragma unroll
        for (int e = 0; e < 16; ++e) { const int i = 16 * qt + e; const float Pe = P[e] + off; const float q = qv[e] * qscale, k = kv[e];
            Qo[i * 128 + d] = (bf16)f2bf(q * __expf(Pe)); Ko[i * 128 + d] = (bf16)f2bf(k * __expf(fminf(-Pe, 80.f))); khT[d * S2 + i] = (bf16)f2bf(k * __expf(total - Pe)); }
        __syncthreads();
#pragma unroll
        for (int e = 0; e < 2; ++e) { const int pc = tid + 512 * e, row = pc >> 3, c8 = (pc & 7) * 8; *(u32x4*)(KHo + row * 64 + c8) = *(const LAS u32x4*)(khT + row * S2 + c8); }
    }
}
template <bool LAT>
__device__ __forceinline__ void gla_unit2(Frame& F, int uid, const bf16* PROJ, const unsigned char* GP, bf16* O, const float* state_in, float* state_out) {
    constexpr int S1 = 136, S2 = 72;
    LAS bf16* qS = (LAS bf16*)F.lds;
    LAS bf16* kS = qS + 64 * S1;
    LAS bf16* khT = kS + 64 * S1;
    LAS bf16* vT = khT + 128 * S2;
    LAS bf16* At = vT + 64 * S2;
    LAS bf16* Sb = At + 64 * S2;
    LAS float* gd = (LAS float*)(Sb + 64 * S1);
    const int tid = F.tid, lane = F.lane, w = F.wave, r = lane & 15, g4 = lane >> 4;
    const int vsl = uid & 3, dir = (uid >> 2) & 1, h = (uid >> 3) & 3, b = uid >> 5;
    constexpr int T = LAT ? 1024 : 256, nch = T / 64;
    const int rowbase = LAT ? NCTX + b * 1024 : b * 256;
    f32x4 S[4];
#pragma unroll
    for (int vt = 0; vt < 4; ++vt)
#pragma unroll
        for (int e = 0; e < 4; ++e) S[vt][e] = LAT ? state_in[((size_t)((b * 2 + dir) * 4 + h) * 128 + 16 * w + 4 * g4 + e) * 256 + vsl * 64 + 16 * vt + r] : 0.f;
    __syncthreads();
#pragma unroll
    for (int vt = 0; vt < 4; ++vt) { u32x2 o; o.x = pk4lo(S[vt]); o.y = pk4hi(S[vt]); *(LAS u32x2*)(Sb + (16 * vt + r) * S1 + 16 * w + 4 * g4) = o; }
    u32x4 pq[2], pk[2], ph[2]; unsigned vreg[4]; float pgd = 0.f;
#define GLA_LOAD(c_) do { const int cc_ = dir == 0 ? (c_) : nch - 1 - (c_); const int tok0_ = cc_ * 64; \
        const unsigned char* ub_ = GP + (size_t)((((rowbase + tok0_) >> 6) * 4 + h) * 2 + dir) * GLA_UNIT_BYTES; \
        _Pragma("unroll") for (int e = 0; e < 2; ++e) { const int pc = tid + 512 * e; pq[e] = *(const u32x4*)(ub_ + (size_t)pc * 16); pk[e] = *(const u32x4*)(ub_ + 16384 + (size_t)pc * 16); ph[e] = *(const u32x4*)(ub_ + 32768 + (size_t)pc * 16); } \
        if (tid < 128) pgd = *(const float*)(ub_ + 49152 + tid * 4); \
        _Pragma("unroll") for (int e = 0; e < 4; ++e) vreg[e] = *(const unsigned*)(PROJ + (size_t)(rowbase + tok0_ + 4 * (tid >> 5) + e) * GLA_NP + 1024 + h * 256 + vsl * 64 + (tid & 31) * 2); } while (0)
    GLA_LOAD(0);
#define GLA_STAGE() do { \
        _Pragma("unroll") for (int e = 0; e < 2; ++e) { const int pc = tid + 512 * e; { const int row = pc >> 4, c8 = (pc & 15) * 8; *(LAS u32x4*)(qS + row * S1 + c8) = pq[e]; *(LAS u32x4*)(kS + row * S1 + c8) = pk[e]; } \
            { const int row = pc >> 3, c8 = (pc & 7) * 8; *(LAS u32x4*)(khT + row * S2 + c8) = ph[e]; } } \
        if (tid < 128) gd[tid] = pgd; \
        { const int vp = (tid & 31) * 2, i0 = 4 * (tid >> 5); u32x2 lo, hi;      \
          lo.x = (vreg[0] & 0xffffu) | (vreg[1] << 16); lo.y = (vreg[2] & 0xffffu) | (vreg[3] << 16); hi.x = (vreg[0] >> 16) | (vreg[1] & 0xffff0000u); hi.y = (vreg[2] >> 16) | (vreg[3] & 0xffff0000u); \
          *(LAS u32x2*)(vT + vp * S2 + i0) = lo; *(LAS u32x2*)(vT + (vp + 1) * S2 + i0) = hi; } } while (0)
    GLA_STAGE();
    if (1 < nch) GLA_LOAD(1);
    for (int c = 0; c < nch; ++c) {
        const int cc = dir == 0 ? c : nch - 1 - c, tok0 = cc * 64;
        __syncthreads();
        { const int ti = w >> 1, i = 16 * ti + r;
#pragma unroll
          for (int jj = 0; jj < 2; ++jj) { const int tj = 2 * (w & 1) + jj; f32x4 a = {0.f, 0.f, 0.f, 0.f};
#pragma unroll
              for (int k4 = 0; k4 < 4; ++k4) { const bf16x8 af = *(const LAS bf16x8*)(kS + (16 * tj + r) * S1 + 32 * k4 + 8 * g4), bf = *(const LAS bf16x8*)(qS + i * S1 + 32 * k4 + 8 * g4);
                  a = __builtin_amdgcn_mfma_f32_16x16x32_bf16(af, bf, a, 0, 0, 0); }
#pragma unroll
              for (int e = 0; e < 4; ++e) { const int j = 16 * tj + 4 * g4 + e; const bool ok = dir == 0 ? (j <= i) : (j >= i); a[e] = ok ? a[e] : 0.f; }
              u32x2 o; o.x = pk4lo(a); o.y = pk4hi(a); *(LAS u32x2*)(At + i * S2 + 16 * tj + 4 * g4) = o; } }
        __syncthreads();
        { const int ti = w >> 1, i = 16 * ti + r;
#pragma unroll
          for (int jj = 0; jj < 2; ++jj) { const int vt = 2 * (w & 1) + jj; f32x4 a = {0.f, 0.f, 0.f, 0.f};
#pragma unroll
              for (int k2 = 0; k2 < 2; ++k2) { const bf16x8 af = *(const LAS bf16x8*)(vT + (16 * vt + r) * S2 + 32 * k2 + 8 * g4), bf = *(const LAS bf16x8*)(At + i * S2 + 32 * k2 + 8 * g4);
                  a = __builtin_amdgcn_mfma_f32_16x16x32_bf16(af, bf, a, 0, 0, 0); }
#pragma unroll
              for (int k4 = 0; k4 < 4; ++k4) { const bf16x8 af = *(const LAS bf16x8*)(Sb + (16 * vt + r) * S1 + 32 * k4 + 8 * g4), bf = *(const LAS bf16x8*)(qS + i * S1 + 32 * k4 + 8 * g4);
                  a = __builtin_amdgcn_mfma_f32_16x16x32_bf16(af, bf, a, 0, 0, 0); }
              { u32x2 o; o.x = pk4lo(a); o.y = pk4hi(a); *(u32x2*)(O + ((size_t)dir * M + rowbase + tok0 + i) * D + h * 256 + vsl * 64 + 16 * vt + 4 * g4) = o; } } }
        { const f32x4 gv = *(const LAS f32x4*)(gd + 16 * w + 4 * g4);
#pragma unroll
          for (int vt = 0; vt < 4; ++vt) { f32x4 a = {0.f, 0.f, 0.f, 0.f};
#pragma unroll
              for (int k2 = 0; k2 < 2; ++k2) { const bf16x8 af = *(const LAS bf16x8*)(khT + (16 * w + r) * S2 + 32 * k2 + 8 * g4), bf = *(const LAS bf16x8*)(vT + (16 * vt + r) * S2 + 32 * k2 + 8 * g4);
                  a = __builtin_amdgcn_mfma_f32_16x16x32_bf16(af, bf, a, 0, 0, 0); }
              S[vt] = S[vt] * gv + a; } }
        __syncthreads();
#pragma unroll
        for (int vt = 0; vt < 4; ++vt) { u32x2 o; o.x = pk4lo(S[vt]); o.y = pk4hi(S[vt]); *(LAS u32x2*)(Sb + (16 * vt + r) * S1 + 16 * w + 4 * g4) = o; }
        if (c + 1 < nch) { GLA_STAGE(); if (c + 2 < nch) GLA_LOAD(c + 2); }
    }
#undef GLA_STAGE
#undef GLA_LOAD
    if (!LAT) {
#pragma unroll
        for (int vt = 0; vt < 4; ++vt)
#pragma unroll
            for (int e = 0; e < 4; ++e) state_out[((size_t)((b * 2 + dir) * 4 + h) * 128 + 16 * w + 4 * g4 + e) * 256 + vsl * 64 + 16 * vt + r] = S[vt][e];
    }
}
__device__ __forceinline__ void gla_core_phase(Frame& F, const bf16* PROJ, const unsigned char* GP, bf16* O, const float* state_in, float* state_out) {
    if (F.G == 256) {
        if (F.bid < 64) { gla_unit2<true>(F, F.bid, PROJ, GP, O, state_in, state_out); gla_unit2<false>(F, F.bid, PROJ, GP, O, state_in, state_out); }
        else { for (int j = 0; j < 5; ++j) gla_unit2<false>(F, 64 + (F.bid - 64) * 5 + j, PROJ, GP, O, state_in, state_out); }
    } else {
        for (int u = F.bid; u < 64 + 1024; u += F.G) { if (u < 64) gla_unit2<true>(F, u, PROJ, GP, O, state_in, state_out); else gla_unit2<false>(F, u - 64, PROJ, GP, O, state_in, state_out); }
    }
}
__device__ __forceinline__ void gla_combine_phase(Frame& F, const bf16* PROJ, const bf16* O, const float* gn, bf16* Gout) {
    const int gw = F.bid * NWAVES + F.wave, NGW = F.G * NWAVES;
    constexpr int RB = 5;
    f32x4 gg[4];
#pragma unroll
    for (int j = 0; j < 4; ++j) gg[j] = *(const f32x4*)(gn + 256 * j + 4 * F.lane);
    for (int base = gw; base < M; base += RB * NGW) {
        u32x2 of[RB][4], ob[RB][4], rr[RB][4];
#pragma unroll
        for (int k = 0; k < RB; ++k) { const int row = base + k * NGW, rc = row < M ? row : gw;
#pragma unroll
            for (int j = 0; j < 4; ++j) { const int c = 256 * j + 4 * F.lane; of[k][j] = __builtin_nontemporal_load((const u32x2*)(O + (size_t)rc * D + c)); ob[k][j] = __builtin_nontemporal_load((const u32x2*)(O + ((size_t)M + rc) * D + c)); rr[k][j] = __builtin_nontemporal_load((const u32x2*)(PROJ + (size_t)rc * GLA_NP + 2048 + c)); } }
#pragma unroll
        for (int k = 0; k < RB; ++k) { const int row = base + k * NGW;
#pragma unroll
            for (int j = 0; j < 4; ++j) { const int c = 256 * j + 4 * F.lane;
                const f32x4 o = {bflo(of[k][j].x) + bflo(ob[k][j].x), bfhi(of[k][j].x) + bfhi(ob[k][j].x), bflo(of[k][j].y) + bflo(ob[k][j].y), bfhi(of[k][j].y) + bfhi(ob[k][j].y)};
                const float ss = wave_sum((o[0] * o[0] + o[1] * o[1]) + (o[2] * o[2] + o[3] * o[3]));
                const float rstd = 1.0f / sqrtf(ss * (1.0f / 256.0f) + 1e-6f);
                const f32x4 r = {bflo(rr[k][j].x), bfhi(rr[k][j].x), bflo(rr[k][j].y), bfhi(rr[k][j].y)};
                f32x4 y = o * rstd * gg[j]; y[0] *= silu_f(r[0]); y[1] *= silu_f(r[1]); y[2] *= silu_f(r[2]); y[3] *= silu_f(r[3]);
                if (row < M) { u32x2 p; p.x = pk2(y[0], y[1]); p.y = pk2(y[2], y[3]); *(u32x2*)(Gout + (size_t)row * D + c) = p; } } }
    }
}

struct EpiNatQKV {
    static constexpr bool HALF_OK = true; static constexpr bool PERM = false; static constexpr bool XPF = false;
    bf16* Q; bf16* K; bf16* VTC; bf16* VTL; float* outK; float* outV; const float* ssq; const float* sw;
    __device__ __forceinline__ void operator()(AccRef acc, const pg8::Unit& u, int wr, int wc, int fr, int fq) const {
        const int part = u.pn >> 2, colbase = (u.pn & 3) * 256 + 128 * u.bsel + wc * 32 + 4 * fq, row0 = u.pm * 256 + wr * 64 + fr;
        const bool ctx = u.pm < 32;
        float rs[2][4];
#pragma unroll
        for (int ai = 0; ai < 2; ++ai)
#pragma unroll
            for (int m = 0; m < 4; ++m) rs[ai][m] = ssq[row0 + ai * 128 + m * 16];
        const float* swc = sw + (size_t)cond_of_row(u.pm * 256) * SWN + u.pn * 256 + 128 * u.bsel + wc * 32 + 4 * fq;
        f32x4 sv[2][2];
#pragma unroll
        for (int bj = 0; bj < 2; ++bj)
#pragma unroll
            for (int n = 0; n < 2; ++n) sv[bj][n] = *(const f32x4*)(swc + bj * 128 + n * 16);
#pragma unroll
        for (int ai = 0; ai < 2; ++ai)
#pragma unroll
            for (int m = 0; m < 4; ++m) { const int row = row0 + ai * 128 + m * 16; const float r1 = 1.0f / sqrtf(rs[ai][m] * (1.0f / 1024.0f) + 1e-6f);
#pragma unroll
                for (int bj = 0; bj < 2; ++bj)
#pragma unroll
                    for (int n = 0; n < 2; ++n) { if (bj >= u.nb) continue; const int c = colbase + bj * 128 + n * 16; const f32x4 v = acc[ai][bj][m][n] * r1 + sv[bj][n]; const int hh = c >> 6, d = c & 63;
                        if (part == 0) { u32x2 p; p.x = pk2(v[0] * 0.125f, v[1] * 0.125f); p.y = pk2(v[2] * 0.125f, v[3] * 0.125f); *(u32x2*)(Q + (size_t)row * D + c) = p; }
                        else if (part == 1) { u32x2 p; p.x = pk2(v[0], v[1]); p.y = pk2(v[2], v[3]); *(u32x2*)(K + (size_t)row * D + c) = p;
                            if (ctx) { const int b = row >> 8, sq = row & 255; *(f32x4*)(outK + ((size_t)(b * 16 + hh) * 256 + sq) * 64 + d) = v; } }
                        else { if (ctx) { const int b = row >> 8, sq = row & 255; *(f32x4*)(outV + ((size_t)(b * 16 + hh) * 256 + sq) * 64 + d) = v;
#pragma unroll
                                for (int e = 0; e < 4; ++e) VTC[((size_t)(b * 16 + hh) * 64 + d + e) * 256 + sq] = (bf16)f2bf(v[e]); }
                            else { const int bl = (row - NCTX) >> 10, t = (row - NCTX) & 1023;
#pragma unroll
                                for (int e = 0; e < 4; ++e) VTL[((size_t)(bl * 16 + hh) * 64 + d + e) * 1024 + t] = (bf16)f2bf(v[e]); } } } }
    }
};
struct KVGroup { const bf16* k; int kstep, kst; const bf16* v; int vstep, vst; };
struct NatState { float m, l; f32x4 o[4]; };
template <bool BIAS>
__device__ __forceinline__ void nat_group(int r, int g, const bf16x8 (&qf)[2], const KVGroup G, NatState& st, const LAS float* rpb_h, int qrow, int rbase, int cbase, int n16) {
    constexpr int NS = 8;
    f32x4 sc[NS][2];
    bf16x8 kf[2][2][2];
#define NAT_LOADK(s_, buf_) do { _Pragma("unroll") for (int t = 0; t < 2; ++t) { const bf16* kr = G.k + (size_t)(s_) * G.kstep + (size_t)(16 * t + r) * G.kst + 8 * g; kf[buf_][t][0] = *(const bf16x8*)kr; kf[buf_][t][1] = *(const bf16x8*)(kr + 32); } } while (0)
    NAT_LOADK(0, 0);
#pragma unroll
    for (int s = 0; s < NS; ++s) {
        if (s + 1 < NS) NAT_LOADK(s + 1, (s + 1) & 1);
#pragma unroll
        for (int t = 0; t < 2; ++t) { f32x4 a = {0.f, 0.f, 0.f, 0.f};
            a = __builtin_amdgcn_mfma_f32_16x16x32_bf16(kf[s & 1][t][0], qf[0], a, 0, 0, 0);
            a = __builtin_amdgcn_mfma_f32_16x16x32_bf16(kf[s & 1][t][1], qf[1], a, 0, 0, 0);
            sc[s][t] = a; }
        __builtin_amdgcn_sched_barrier(0);
    }
#undef NAT_LOADK
    if (BIAS) {
        const int qcol = n16 + r; int cstart = qcol - 8; cstart = cstart < 0 ? 0 : (cstart > 48 ? 48 : cstart);
#pragma unroll
        for (int s = 0; s < NS; ++s) { const int dri = rbase + s - qrow + 7;
#pragma unroll
            for (int t = 0; t < 2; ++t)
#pragma unroll
                for (int e = 0; e < 4; ++e) { const int kc = cbase + 16 * t + 4 * g + e; int dci = kc - qcol + 15; dci = dci < 0 ? 0 : (dci > 30 ? 30 : dci);
                    const bool ok = kc >= cstart && kc < cstart + 16;
                    const float bias = rpb_h[dri * 31 + dci];
                    sc[s][t][e] = ok ? sc[s][t][e] + bias : -1e30f; } }
    }
    float mx = st.m;
#pragma unroll
    for (int s = 0; s < NS; ++s)
#pragma unroll
        for (int t = 0; t < 2; ++t) mx = fmaxf(mx, fmaxf(fmaxf(sc[s][t][0], sc[s][t][1]), fmaxf(sc[s][t][2], sc[s][t][3])));
    mx = fmaxf(mx, __shfl_xor(mx, 16)); mx = fmaxf(mx, __shfl_xor(mx, 32));
    const float alpha = __expf(st.m - mx);
    st.m = mx; st.l *= alpha;
#pragma unroll
    for (int dt = 0; dt < 4; ++dt) st.o[dt] = st.o[dt] * alpha;
    u32x2 vf[2][4][2];
#define NAT_LOADV(s_, buf_) do { _Pragma("unroll") for (int dt = 0; dt < 4; ++dt) { const bf16* vr = G.v + (size_t)(s_) * G.vstep + (size_t)(16 * dt + r) * G.vst + 4 * g; \
        vf[buf_][dt][0] = *(const u32x2*)vr; vf[buf_][dt][1] = *(const u32x2*)(vr + 16); } } while (0)
    NAT_LOADV(0, 0);
#pragma unroll
    for (int s = 0; s < NS; ++s) {
        if (s + 1 < NS) NAT_LOADV(s + 1, (s + 1) & 1);
        unsigned pw[4];
#pragma unroll
        for (int t = 0; t < 2; ++t) { const float p0 = __expf(sc[s][t][0] - mx), p1 = __expf(sc[s][t][1] - mx), p2 = __expf(sc[s][t][2] - mx), p3 = __expf(sc[s][t][3] - mx);
            pw[2 * t] = pk2(p0, p1); pw[2 * t + 1] = pk2(p2, p3);
            st.l += (bflo(pw[2 * t]) + bfhi(pw[2 * t])) + (bflo(pw[2 * t + 1]) + bfhi(pw[2 * t + 1])); }
        const u32x4 pu = {pw[0], pw[1], pw[2], pw[3]};
        const bf16x8 pf = __builtin_bit_cast(bf16x8, pu);
#pragma unroll
        for (int dt = 0; dt < 4; ++dt) { const u32x4 vu = {vf[s & 1][dt][0].x, vf[s & 1][dt][0].y, vf[s & 1][dt][1].x, vf[s & 1][dt][1].y};
            st.o[dt] = __builtin_amdgcn_mfma_f32_16x16x32_bf16(__builtin_bit_cast(bf16x8, vu), pf, st.o[dt], 0, 0, 0); }
        __builtin_amdgcn_sched_barrier(0);
    }
#undef NAT_LOADV
}
template <bool LAT>
__device__ __forceinline__ void nat_wave_unit(int lane, const bf16* qp  , const KVGroup g0, const KVGroup g1,
                                              bf16* op, const LAS float* rpb_h, int qrow, int rbase, int cbase, int n16) {
    const int r = lane & 15, g = lane >> 4;
    bf16x8 qf[2];
#pragma unroll
    for (int k2 = 0; k2 < 2; ++k2) qf[k2] = *(const bf16x8*)(qp + (size_t)r * D + 32 * k2 + 8 * g);
    NatState st; st.m = -3e38f; st.l = 0.f;
#pragma unroll
    for (int dt = 0; dt < 4; ++dt) st.o[dt] = (f32x4){0.f, 0.f, 0.f, 0.f};
    nat_group<LAT>(r, g, qf, g0, st, rpb_h, qrow, rbase, cbase, n16);
    if (LAT) nat_group<false>(r, g, qf, g1, st, rpb_h, qrow, rbase, cbase, n16);
    float lsum = st.l;
    lsum += __shfl_xor(lsum, 16); lsum += __shfl_xor(lsum, 32);
    const float inv = 1.0f / lsum;
#pragma unroll
    for (int dt = 0; dt < 4; ++dt) { u32x2 o; o.x = pk2(st.o[dt][0] * inv, st.o[dt][1] * inv); o.y = pk2(st.o[dt][2] * inv, st.o[dt][3] * inv);
        *(u32x2*)(op + (size_t)r * D + 16 * dt + 4 * g) = o; }
}
__device__ __forceinline__ void nat_ctx_unit_lds(int lane, const bf16x8 (&qf)[2], const LAS bf16* Ks  , const LAS bf16* Vs  , bf16* op) {
    constexpr int NS = 8, KS = 72, VS = 264;
    const int r = lane & 15, g = lane >> 4;
    f32x4 sc[NS][2];
#pragma unroll
    for (int s = 0; s < NS; ++s)
#pragma unroll
        for (int t = 0; t < 2; ++t) { const LAS bf16* kr = Ks + (32 * s + 16 * t + r) * KS + 8 * g;
            const bf16x8 k0 = *(const LAS bf16x8*)kr, k1 = *(const LAS bf16x8*)(kr + 32);
            f32x4 a = {0.f, 0.f, 0.f, 0.f};
            a = __builtin_amdgcn_mfma_f32_16x16x32_bf16(k0, qf[0], a, 0, 0, 0);
            a = __builtin_amdgcn_mfma_f32_16x16x32_bf16(k1, qf[1], a, 0, 0, 0);
            sc[s][t] = a; __builtin_amdgcn_sched_barrier(0); }
    float mx = -3e38f;
#pragma unroll
    for (int s = 0; s < NS; ++s)
#pragma unroll
        for (int t = 0; t < 2; ++t) mx = fmaxf(mx, fmaxf(fmaxf(sc[s][t][0], sc[s][t][1]), fmaxf(sc[s][t][2], sc[s][t][3])));
    mx = fmaxf(mx, __shfl_xor(mx, 16)); mx = fmaxf(mx, __shfl_xor(mx, 32));
    float lsum = 0.f; f32x4 oacc[4];
#pragma unroll
    for (int dt = 0; dt < 4; ++dt) oacc[dt] = (f32x4){0.f, 0.f, 0.f, 0.f};
#pragma unroll
    for (int s = 0; s < NS; ++s) {
        unsigned pw[4];
#pragma unroll
        for (int t = 0; t < 2; ++t) { const float p0 = __expf(sc[s][t][0] - mx), p1 = __expf(sc[s][t][1] - mx), p2 = __expf(sc[s][t][2] - mx), p3 = __expf(sc[s][t][3] - mx);
            pw[2 * t] = pk2(p0, p1); pw[2 * t + 1] = pk2(p2, p3);
            lsum += (bflo(pw[2 * t]) + bfhi(pw[2 * t])) + (bflo(pw[2 * t + 1]) + bfhi(pw[2 * t + 1])); }
        const u32x4 pu = {pw[0], pw[1], pw[2], pw[3]};
        const bf16x8 pf = __builtin_bit_cast(bf16x8, pu);
#pragma unroll
        for (int dt = 0; dt < 4; ++dt) { const LAS bf16* vr = Vs + (16 * dt + r) * VS + 32 * s + 4 * g;
            const u32x2 v0 = *(const LAS u32x2*)vr, v1 = *(const LAS u32x2*)(vr + 16);
            const u32x4 vu = {v0.x, v0.y, v1.x, v1.y};
            oacc[dt] = __builtin_amdgcn_mfma_f32_16x16x32_bf16(__builtin_bit_cast(bf16x8, vu), pf, oacc[dt], 0, 0, 0); }
        __builtin_amdgcn_sched_barrier(0);
    }
    lsum += __shfl_xor(lsum, 16); lsum += __shfl_xor(lsum, 32);
    const float inv = 1.0f / lsum;
#pragma unroll
    for (int dt = 0; dt < 4; ++dt) { u32x2 o; o.x = pk2(oacc[dt][0] * inv, oacc[dt][1] * inv); o.y = pk2(oacc[dt][2] * inv, oacc[dt][3] * inv);
        *(u32x2*)(op + (size_t)r * D + 16 * dt + 4 * g) = o; }
}
template <bool BIAS>
__device__ __forceinline__ void nat_scores_lds(int r, int g, const bf16x8 (&qf)[2], const LAS bf16* Kl  , int kstep  , f32x4 (&sc)[8][2], NatState& st,
                                               const LAS float* rpb_h, int qrow, int rbase, int cbase, int n16) {
    constexpr int NS = 8;
#pragma unroll
    for (int s = 0; s < NS; ++s)
#pragma unroll
        for (int t = 0; t < 2; ++t) { const LAS bf16* kr = Kl + s * kstep + (16 * t + r) * 72 + 8 * g;
            const bf16x8 k0 = *(const LAS bf16x8*)kr, k1 = *(const LAS bf16x8*)(kr + 32);
            f32x4 a = {0.f, 0.f, 0.f, 0.f};
            a = __builtin_amdgcn_mfma_f32_16x16x32_bf16(k0, qf[0], a, 0, 0, 0);
            a = __builtin_amdgcn_mfma_f32_16x16x32_bf16(k1, qf[1], a, 0, 0, 0);
            sc[s][t] = a; __builtin_amdgcn_sched_barrier(0); }
    if (BIAS) {
        const int qcol = n16 + r; int cstart = qcol - 8; cstart = cstart < 0 ? 0 : (cstart > 48 ? 48 : cstart);
#pragma unroll
        for (int s = 0; s < NS; ++s) { const int dri = rbase + s - qrow + 7;
#pragma unroll
            for (int t = 0; t < 2; ++t)
#pragma unroll
                for (int e = 0; e < 4; ++e) { const int kc = cbase + 16 * t + 4 * g + e; int dci = kc - qcol + 15; dci = dci < 0 ? 0 : (dci > 30 ? 30 : dci);
                    const bool ok = kc >= cstart && kc < cstart + 16;
                    const float bias = rpb_h[dri * 31 + dci];
                    sc[s][t][e] = ok ? sc[s][t][e] + bias : -1e30f; } }
    }
    float mx = st.m;
#pragma unroll
    for (int s = 0; s < NS; ++s)
#pragma unroll
        for (int t = 0; t < 2; ++t) mx = fmaxf(mx, fmaxf(fmaxf(sc[s][t][0], sc[s][t][1]), fmaxf(sc[s][t][2], sc[s][t][3])));
    mx = fmaxf(mx, __shfl_xor(mx, 16)); mx = fmaxf(mx, __shfl_xor(mx, 32));
    const float alpha = __expf(st.m - mx);
    st.m = mx; st.l *= alpha;
#pragma unroll
    for (int dt = 0; dt < 4; ++dt) st.o[dt] = st.o[dt] * alpha;
}
__device__ __forceinline__ void nat_pv_lds(int r, int g, const LAS bf16* Vl  , int vstep, int vstride, const f32x4 (&sc)[8][2], NatState& st) {
    constexpr int NS = 8;
    const float mx = st.m;
#pragma unroll
    for (int s = 0; s < NS; ++s) {
        unsigned pw[4];
#pragma unroll
        for (int t = 0; t < 2; ++t) { const float p0 = __expf(sc[s][t][0] - mx), p1 = __expf(sc[s][t][1] - mx), p2 = __expf(sc[s][t][2] - mx), p3 = __expf(sc[s][t][3] - mx);
            pw[2 * t] = pk2(p0, p1); pw[2 * t + 1] = pk2(p2, p3);
            st.l += (bflo(pw[2 * t]) + bfhi(pw[2 * t])) + (bflo(pw[2 * t + 1]) + bfhi(pw[2 * t + 1])); }
        const u32x4 pu = {pw[0], pw[1], pw[2], pw[3]};
        const bf16x8 pf = __builtin_bit_cast(bf16x8, pu);
#pragma unroll
        for (int dt = 0; dt < 4; ++dt) { const LAS bf16* vr = Vl + (16 * dt + r) * vstride + s * vstep + 4 * g;
            const u32x2 v0 = *(const LAS u32x2*)vr, v1 = *(const LAS u32x2*)(vr + 16);
            const u32x4 vu = {v0.x, v0.y, v1.x, v1.y};
            st.o[dt] = __builtin_amdgcn_mfma_f32_16x16x32_bf16(__builtin_bit_cast(bf16x8, vu), pf, st.o[dt], 0, 0, 0); }
        __builtin_amdgcn_sched_barrier(0);
    }
}
__device__ __forceinline__ void nat_attn_phase(Frame& F, const bf16* Q, const bf16* K, const bf16* VTC, const bf16* VTL, const bf16* CK, const bf16* CVT, const float* rpb, bf16* ATT) {
    { LAS bf16* Ks = (LAS bf16*)F.lds; LAS bf16* Vs = Ks + 256 * 72;
      u32x4 pk[4], pv[4];
#define NAT_CTX_LOAD(bh_) do { const int b_ = (bh_) >> 4, h_ = (bh_) & 15; \
        _Pragma("unroll") for (int e = 0; e < 4; ++e) { const int pc = F.tid + 512 * e; pk[e] = *(const u32x4*)(K + (size_t)(b_ * 256 + (pc >> 3)) * D + h_ * 64 + (pc & 7) * 8); \
            pv[e] = *(const u32x4*)(VTC + (size_t)((bh_) * 64 + (pc >> 5)) * 256 + (pc & 31) * 8); } } while (0)
      if (F.bid < 512) NAT_CTX_LOAD(F.bid);
      for (int bh = F.bid; bh < 512; bh += F.G) { const int b = bh >> 4, h = bh & 15, r = F.lane & 15, g = F.lane >> 4;
        bf16x8 qf[2][2];
#pragma unroll
        for (int i = 0; i < 2; ++i)
#pragma unroll
            for (int k2 = 0; k2 < 2; ++k2) qf[i][k2] = *(const bf16x8*)(Q + (size_t)(b * 256 + (F.wave + 8 * i) * 16 + r) * D + h * 64 + 32 * k2 + 8 * g);
        __syncthreads();
#pragma unroll
        for (int e = 0; e < 4; ++e) { const int pc = F.tid + 512 * e; *(LAS u32x4*)(Ks + (pc >> 3) * 72 + (pc & 7) * 8) = pk[e]; *(LAS u32x4*)(Vs + (pc >> 5) * 264 + (pc & 31) * 8) = pv[e]; }
        if (bh + F.G < 512) NAT_CTX_LOAD(bh + F.G);
        __syncthreads();
#pragma unroll
        for (int i = 0; i < 2; ++i) { const int row0 = b * 256 + (F.wave + 8 * i) * 16;
            nat_ctx_unit_lds(F.lane, qf[i], Ks, Vs, ATT + (size_t)row0 * D + h * 64); }
      }
#undef NAT_CTX_LOAD
    }
    LAS bf16* R = (LAS bf16*)F.lds; LAS float* rpbs = (LAS float*)(F.lds + 84992);
    for (int wu = F.bid; wu < 256; wu += F.G) { const int rp = wu & 7, h = (wu >> 3) & 15, bl = wu >> 7, n = F.wave & 3, rq = 2 * rp + (F.wave >> 2);
        const int tid = F.tid, r = F.lane & 15, g = F.lane >> 4;
        int rb0 = 2 * rp - 4; rb0 = rb0 < 0 ? 0 : (rb0 > 8 ? 8 : rb0); const int wstart = rb0 > 7 ? 7 : rb0;
        int rbase = rq - 4; rbase = rbase < 0 ? 0 : (rbase > 8 ? 8 : rbase);
        int cbase = 16 * n - 8; cbase = cbase < 0 ? 0 : (cbase > 32 ? 32 : cbase);
        const bf16* kwin = K + (size_t)(NCTX + bl * 1024 + wstart * 64) * D + h * 64;
        const bf16* vwin = VTL + (size_t)((bl * 16 + h) * 64) * 1024 + wstart * 64;
        const int row0 = NCTX + bl * 1024 + rq * 64 + 16 * n;
        const bf16* qp = Q + (size_t)row0 * D + h * 64; bf16* op = ATT + (size_t)row0 * D + h * 64;
        bf16x8 qf[2];
#pragma unroll
        for (int k2 = 0; k2 < 2; ++k2) qf[k2] = *(const bf16x8*)(qp + (size_t)r * D + 32 * k2 + 8 * g);
        u32x4 pre[9];
#pragma unroll
        for (int e = 0; e < 9; ++e) { const int pc = tid + 512 * e; pre[e] = *(const u32x4*)(kwin + (size_t)(pc >> 3) * D + (pc & 7) * 8); }
        __syncthreads();
        if (tid < 465) rpbs[tid] = rpb[(size_t)h * 465 + tid];
#pragma unroll
        for (int e = 0; e < 9; ++e) { const int pc = tid + 512 * e; *(LAS u32x4*)(R + (pc >> 3) * 72 + (pc & 7) * 8) = pre[e]; }
#pragma unroll
        for (int e = 0; e < 9; ++e) { const int pc = tid + 512 * e, d = pc / 72, c = pc - d * 72; pre[e] = *(const u32x4*)(vwin + (size_t)d * 1024 + c * 8); }
        __syncthreads();
        NatState st; st.m = -3e38f; st.l = 0.f;
#pragma unroll
        for (int dt = 0; dt < 4; ++dt) st.o[dt] = (f32x4){0.f, 0.f, 0.f, 0.f};
        f32x4 sc[8][2];
        nat_scores_lds<true>(r, g, qf, R + ((rbase - wstart) * 64 + cbase) * 72, 64 * 72, sc, st, rpbs, rq, rbase, cbase, 16 * n);
        __syncthreads();
#pragma unroll
        for (int e = 0; e < 9; ++e) { const int pc = tid + 512 * e, d = pc / 72, c = pc - d * 72; *(LAS u32x4*)(R + d * 584 + c * 8) = pre[e]; }
#pragma unroll
        for (int e = 0; e < 4; ++e) { const int pc = tid + 512 * e; pre[e] = *(const u32x4*)(CK + (size_t)(bl * 16 + h) * 256 * 64 + (size_t)pc * 8);
            pre[4 + e] = *(const u32x4*)(CVT + ((size_t)((bl * 16 + h) * 64) + (pc >> 5)) * 256 + (pc & 31) * 8); }
        __syncthreads();
        nat_pv_lds(r, g, R + (rbase - wstart) * 64 + cbase, 64, 584, sc, st);
        __syncthreads();
#pragma unroll
        for (int e = 0; e < 4; ++e) { const int pc = tid + 512 * e; *(LAS u32x4*)(R + (pc >> 3) * 72 + (pc & 7) * 8) = pre[e]; *(LAS u32x4*)(R + 256 * 72 + (pc >> 5) * 264 + (pc & 31) * 8) = pre[4 + e]; }
        __syncthreads();
        nat_scores_lds<false>(r, g, qf, R, 32 * 72, sc, st, rpbs, rq, rbase, cbase, 16 * n);
        nat_pv_lds(r, g, R + 256 * 72, 32, 264, sc, st);
        float lsum = st.l;
        lsum += __shfl_xor(lsum, 16); lsum += __shfl_xor(lsum, 32);
        const float inv = 1.0f / lsum;
#pragma unroll
        for (int dt = 0; dt < 4; ++dt) { u32x2 o; o.x = pk2(st.o[dt][0] * inv, st.o[dt][1] * inv); o.y = pk2(st.o[dt][2] * inv, st.o[dt][3] * inv);
            *(u32x2*)(op + (size_t)r * D + 16 * dt + 4 * g) = o; }
    }
}


__device__ __forceinline__ float gelu_tanh(float x) { const float y = 0.7978845608028654f * (x + 0.044715f * x * x * x); return x * fast_rcp(1.0f + __expf(-2.0f * y)); }
struct EpiGmlpIn {
    static constexpr bool HALF_OK = true; static constexpr bool PERM = false; static constexpr bool XPF = false;
    bf16* U; bf16* V; const float* ssq; const float* sw; float* ln1; float* ln2; float addss;
    __device__ __forceinline__ void operator()(AccRef acc, const pg8::Unit& u, int wr, int wc, int fr, int fq) const {
        const bool isu = u.pn < 4; const int colbase = (u.pn & 3) * 256 + 128 * u.bsel + wc * 32 + 4 * fq, row0 = u.pm * 256 + wr * 64 + fr;
        float rs[2][4];
#pragma unroll
        for (int ai = 0; ai < 2; ++ai)
#pragma unroll
            for (int m = 0; m < 4; ++m) rs[ai][m] = ssq[row0 + ai * 128 + m * 16];
        const float* swc = sw + (size_t)cond_of_row(u.pm * 256) * SWN + u.pn * 256 + 128 * u.bsel + wc * 32 + 4 * fq;
        f32x4 sv[2][2];
#pragma unroll
        for (int bj = 0; bj < 2; ++bj)
#pragma unroll
            for (int n = 0; n < 2; ++n) sv[bj][n] = *(const f32x4*)(swc + bj * 128 + n * 16);
#pragma unroll
        for (int ai = 0; ai < 2; ++ai)
#pragma unroll
            for (int m = 0; m < 4; ++m) { const int row = row0 + ai * 128 + m * 16; const float r1 = 1.0f / sqrtf(rs[ai][m] * (1.0f / 1024.0f) + 1e-6f); float s1 = 0.f, s2 = 0.f;
#pragma unroll
                for (int bj = 0; bj < 2; ++bj)
#pragma unroll
                    for (int n = 0; n < 2; ++n) { if (bj >= u.nb) continue; const int c = colbase + bj * 128 + n * 16; f32x4 v = acc[ai][bj][m][n] * r1 + sv[bj][n];
                        v[0] = gelu_tanh(v[0]); v[1] = gelu_tanh(v[1]); v[2] = gelu_tanh(v[2]); v[3] = gelu_tanh(v[3]);
                        if (isu) { u32x2 p; p.x = pk2(v[0], v[1]); p.y = pk2(v[2], v[3]); *(u32x2*)(U + (size_t)row * D + c) = p; }
                        else { u32x2 p; p.x = pk2(v[0], v[1]); p.y = pk2(v[2], v[3]); *(u32x2*)(V + (size_t)row * D + c) = p;
                            const f32x4 q = {bflo(p.x), bfhi(p.x), bflo(p.y), bfhi(p.y)};
                            s1 += (q[0] + q[1]) + (q[2] + q[3]); s2 += (q[0] * q[0] + q[1] * q[1]) + (q[2] * q[2] + q[3] * q[3]); } }
                if (!isu) { s1 += __shfl_xor(s1, 16); s1 += __shfl_xor(s1, 32); s2 += __shfl_xor(s2, 16); s2 += __shfl_xor(s2, 32);
                    if (fq == 0) { atomicAdd(ln1 + row, s1 * addss); atomicAdd(ln2 + row, s2 * addss); } } }
    }
};
__device__ __forceinline__ void gm_ln_phase(Frame& F, const bf16* V, const float* lg, const float* lb, bf16* VN) {
    const int gw = F.bid * NWAVES + F.wave, NGW = F.G * NWAVES;
    constexpr int RB = 5;
    f32x4 gg[4], bb[4];
#pragma unroll
    for (int j = 0; j < 4; ++j) { gg[j] = *(const f32x4*)(lg + 4 * F.lane + 256 * j); bb[j] = *(const f32x4*)(lb + 4 * F.lane + 256 * j); }
    for (int base = gw; base < M; base += RB * NGW) {
        f32x4 v[RB][4];
#pragma unroll
        for (int k = 0; k < RB; ++k) { const int row = base + k * NGW, rc = row < M ? row : gw;
#pragma unroll
            for (int j = 0; j < 4; ++j) { const u32x2 vr = *(const u32x2*)(V + (size_t)rc * D + 4 * F.lane + 256 * j); v[k][j] = (f32x4){bflo(vr.x), bfhi(vr.x), bflo(vr.y), bfhi(vr.y)}; } }
#pragma unroll
        for (int k = 0; k < RB; ++k) { const int row = base + k * NGW; float s = 0.f;
#pragma unroll
            for (int j = 0; j < 4; ++j) s += (v[k][j][0] + v[k][j][1]) + (v[k][j][2] + v[k][j][3]);
            const float mean = wave_sum(s) * (1.0f / D); float s2 = 0.f;
#pragma unroll
            for (int j = 0; j < 4; ++j) { v[k][j] = v[k][j] - mean; s2 += (v[k][j][0] * v[k][j][0] + v[k][j][1] * v[k][j][1]) + (v[k][j][2] * v[k][j][2] + v[k][j][3] * v[k][j][3]); }
            const float rstd = 1.0f / sqrtf(wave_sum(s2) * (1.0f / D) + 1e-6f);
            if (row < M) {
#pragma unroll
                for (int j = 0; j < 4; ++j) { const int c = 4 * F.lane + 256 * j; const f32x4 y = v[k][j] * rstd * gg[j] + bb[j];
                    u32x2 p; p.x = pk2(y[0], y[1]); p.y = pk2(y[2], y[3]); *(u32x2*)(VN + (size_t)row * D + c) = p; } } }
    }
}
__device__ __forceinline__ void gm_spatial_phase(Frame& F, const bf16* V, const float* ln1, const float* ln2, const float* lg, const float* lb, const bf16* U, const float* w_s, const float* b_s, bf16* MX) {
    constexpr int LS = 136;
    LAS bf16* As = (LAS bf16*)F.lds;
    LAS bf16* Bs = As + 128 * LS;
    const int tid = F.tid, r = F.lane & 15, g4 = F.lane >> 4, w = F.wave;
    for (int unit = F.bid; unit < 640; unit += F.G) { const int ch = unit >> 3, gg = unit & 7;
        __syncthreads();
#pragma unroll
        for (int e = 0; e < 8; ++e) { const int i4 = tid + 512 * e, p = i4 >> 5, q4 = (i4 & 31) * 4; const f32x4 v = *(const f32x4*)(w_s + ((size_t)gg * 128 + p) * 128 + q4);
            u32x2 o; o.x = pk2(v[0], v[1]); o.y = pk2(v[2], v[3]); *(LAS u32x2*)(As + p * LS + q4) = o; }
        { const int q0 = 8 * (tid >> 5), c4 = (tid & 31) * 4; u32x2 v[8];
          float m1[8], m2[8];
#pragma unroll
          for (int e = 0; e < 8; ++e) { v[e] = *(const u32x2*)(V + (size_t)(ch * 128 + q0 + e) * D + gg * 128 + c4); m1[e] = ln1[ch * 128 + q0 + e]; m2[e] = ln2[ch * 128 + q0 + e]; }
          const f32x4 lgv = *(const f32x4*)(lg + gg * 128 + c4), lbv = *(const f32x4*)(lb + gg * 128 + c4);
#pragma unroll
          for (int e = 0; e < 8; ++e) { const float mean = m1[e] * (1.0f / D), var = fmaxf(m2[e] * (1.0f / D) - mean * mean, 0.f), rstd = 1.0f / sqrtf(var + 1e-6f);
              const f32x4 vf = {bflo(v[e].x), bfhi(v[e].x), bflo(v[e].y), bfhi(v[e].y)};
              const f32x4 y = (vf - mean) * rstd * lgv + lbv; v[e].x = pk2(y[0], y[1]); v[e].y = pk2(y[2], y[3]); }
          u32x4 o0, o1, o2, o3;
          o0.x = (v[0].x & 0xffffu) | (v[1].x << 16); o0.y = (v[2].x & 0xffffu) | (v[3].x << 16); o0.z = (v[4].x & 0xffffu) | (v[5].x << 16); o0.w = (v[6].x & 0xffffu) | (v[7].x << 16);
          o1.x = (v[0].x >> 16) | (v[1].x & 0xffff0000u); o1.y = (v[2].x >> 16) | (v[3].x & 0xffff0000u); o1.z = (v[4].x >> 16) | (v[5].x & 0xffff0000u); o1.w = (v[6].x >> 16) | (v[7].x & 0xffff0000u);
          o2.x = (v[0].y & 0xffffu) | (v[1].y << 16); o2.y = (v[2].y & 0xffffu) | (v[3].y << 16); o2.z = (v[4].y & 0xffffu) | (v[5].y << 16); o2.w = (v[6].y & 0xffffu) | (v[7].y << 16);
          o3.x = (v[0].y >> 16) | (v[1].y & 0xffff0000u); o3.y = (v[2].y >> 16) | (v[3].y & 0xffff0000u); o3.z = (v[4].y >> 16) | (v[5].y & 0xffff0000u); o3.w = (v[6].y >> 16) | (v[7].y & 0xffff0000u);
          *(LAS u32x4*)(Bs + (c4 + 0) * LS + q0) = o0; *(LAS u32x4*)(Bs + (c4 + 1) * LS + q0) = o1; *(LAS u32x4*)(Bs + (c4 + 2) * LS + q0) = o2; *(LAS u32x4*)(Bs + (c4 + 3) * LS + q0) = o3; }
        const int p = 16 * w + r, tok = ch * 128 + p; const float bsv = b_s[gg * 128 + p];
        u32x2 uu[8];
#pragma unroll
        for (int ct = 0; ct < 8; ++ct) uu[ct] = *(const u32x2*)(U + (size_t)tok * D + gg * 128 + 16 * ct + 4 * g4);
        __syncthreads();
        f32x4 acc[8];
#pragma unroll
        for (int ct = 0; ct < 8; ++ct) acc[ct] = (f32x4){0.f, 0.f, 0.f, 0.f};
#pragma unroll
        for (int k4 = 0; k4 < 4; ++k4) { const bf16x8 af = *(const LAS bf16x8*)(As + (16 * w + r) * LS + 32 * k4 + 8 * g4);
#pragma unroll
            for (int ct = 0; ct < 8; ++ct) { const bf16x8 bf = *(const LAS bf16x8*)(Bs + (16 * ct + r) * LS + 32 * k4 + 8 * g4);
                acc[ct] = __builtin_amdgcn_mfma_f32_16x16x32_bf16(bf, af, acc[ct], 0, 0, 0); } }
#pragma unroll
        for (int ct = 0; ct < 8; ++ct) { const int c = gg * 128 + 16 * ct + 4 * g4;
            u32x2 o; o.x = pk2((acc[ct][0] + bsv) * bflo(uu[ct].x), (acc[ct][1] + bsv) * bfhi(uu[ct].x)); o.y = pk2((acc[ct][2] + bsv) * bflo(uu[ct].y), (acc[ct][3] + bsv) * bfhi(uu[ct].y));
            *(u32x2*)(MX + (size_t)tok * D + c) = o; }
    }
}

struct EpiSsdIn {
    static constexpr bool HALF_OK = true; static constexpr bool PERM = false; static constexpr bool XPF = false;
    bf16* Z; bf16* XBC; float* DT; const float* ssq; const float* sw;
    __device__ __forceinline__ void operator()(AccRef acc, const pg8::Unit& u, int wr, int wc, int fr, int fq) const {
        const int row0 = u.pm * 256 + wr * 64 + fr, cl = 128 * u.bsel + wc * 32 + 4 * fq;
        float rs[2][4];
#pragma unroll
        for (int ai = 0; ai < 2; ++ai)
#pragma unroll
            for (int m = 0; m < 4; ++m) rs[ai][m] = ssq[row0 + ai * 128 + m * 16];
        const float* swc = sw + (size_t)cond_of_row(u.pm * 256) * SWN + u.pn * 256 + cl;
        f32x4 sv[2][2];
#pragma unroll
        for (int bj = 0; bj < 2; ++bj)
#pragma unroll
            for (int n = 0; n < 2; ++n) sv[bj][n] = *(const f32x4*)(swc + bj * 128 + n * 16);
        if (u.pn < 20) {
            bf16* base; int ld, c0;
            if (u.pn < 8) { base = Z; ld = 2048; c0 = u.pn * 256; } else { base = XBC; ld = 3072; c0 = (u.pn - 8) * 256; }
#pragma unroll
            for (int ai = 0; ai < 2; ++ai)
#pragma unroll
                for (int m = 0; m < 4; ++m) { bf16* rowp = base + (size_t)(row0 + ai * 128 + m * 16) * ld + c0 + cl; const float r1 = 1.0f / sqrtf(rs[ai][m] * (1.0f / 1024.0f) + 1e-6f);
#pragma unroll
                    for (int bj = 0; bj < 2; ++bj)
#pragma unroll
                        for (int n = 0; n < 2; ++n) { if (bj >= u.nb) continue; const f32x4 v = acc[ai][bj][m][n] * r1 + sv[bj][n]; u32x2 o; o.x = pk2(v[0], v[1]); o.y = pk2(v[2], v[3]); *(u32x2*)(rowp + bj * 128 + n * 16) = o; } }
        } else {
#pragma unroll
            for (int ai = 0; ai < 2; ++ai)
#pragma unroll
                for (int m = 0; m < 4; ++m) { float* rowp = DT + (size_t)(row0 + ai * 128 + m * 16) * 64 + cl; const float r1 = 1.0f / sqrtf(rs[ai][m] * (1.0f / 1024.0f) + 1e-6f);
#pragma unroll
                    for (int n = 0; n < 2; ++n) { if (cl + n * 16 < 64) *(f32x4*)(rowp + n * 16) = acc[ai][0][m][n] * r1 + sv[0][n]; } }
        }
    }
};
__device__ __forceinline__ void ssd_conv_phase(Frame& F, const bf16* XBC, const float* DT, float* DTS, float* PCS, const float* alog, const float* cw, const float* cb, const float* dtb, bf16* XT, bf16* BMb, bf16* CMb, bf16* BMT) {
    LAS bf16* tl = (LAS bf16*)F.lds;
    const int tid = F.tid, c2 = (tid & 63) * 2, tg = tid >> 6;
    for (int task = F.bid * NWAVES + F.wave; task < 160 * 64; task += F.G * NWAVES) { const int ch = task >> 6, col = task & 63, dirc = col >> 5; const size_t idx = (size_t)(ch * 64 + F.lane) * 64 + col;
        const float x = DT[idx] + dtb[col]; const float dt = fmaxf(x, 0.f) + log1pf(expf(-fabsf(x))); DTS[idx] = dt;
        float v = dt * -expf(alog[col]);
        if (dirc == 0) {
#pragma unroll
            for (int o = 1; o < 64; o <<= 1) { const float t = __shfl_up(v, o); if (F.lane >= o) v += t; }
        } else {
#pragma unroll
            for (int o = 1; o < 64; o <<= 1) { const float t = __shfl_down(v, o); if (F.lane + o < 64) v += t; }
        }
        PCS[idx] = v; }
    for (int unit = F.bid; unit < 160 * 24; unit += F.G) { const int tb = unit / 24, cbk = unit % 24, ch = cbk * 128 + c2;
        const f32x2 w0 = *(const f32x2*)(cw + ch), w1 = *(const f32x2*)(cw + 3072 + ch), w2 = *(const f32x2*)(cw + 6144 + ch), bb = *(const f32x2*)(cb + ch);
        const int row0 = tb * 64 + tg * 8;
        const int T = row0 < NCTX ? 256 : 1024, pos0 = row0 < NCTX ? (row0 & 255) : ((row0 - NCTX) & 1023);
        unsigned raw[10];
#pragma unroll
        for (int j = 0; j < 10; ++j) { const int pos = pos0 - 1 + j; const bool ok = pos >= 0 && pos < T; const int rr = ok ? row0 - 1 + j : row0; raw[j] = *(const unsigned*)(XBC + (size_t)rr * 3072 + ch); }
        float xa[10], xb[10];
#pragma unroll
        for (int j = 0; j < 10; ++j) { const int pos = pos0 - 1 + j; const bool ok = pos >= 0 && pos < T; xa[j] = ok ? bflo(raw[j]) : 0.f; xb[j] = ok ? bfhi(raw[j]) : 0.f; }
        unsigned yp[8];
#pragma unroll
        for (int j = 0; j < 8; ++j) yp[j] = pk2(silu_f(w0.x * xa[j] + w1.x * xa[j + 1] + w2.x * xa[j + 2] + bb.x), silu_f(w0.y * xb[j] + w1.y * xb[j + 1] + w2.y * xb[j + 2] + bb.y));
        __syncthreads();
        if (cbk >= 16 && cbk < 20) {
#pragma unroll
            for (int j = 0; j < 8; ++j) *(unsigned*)(BMb + (size_t)(row0 + j) * 512 + ch - 2048) = yp[j];
        } else if (cbk >= 20) {
#pragma unroll
            for (int j = 0; j < 8; ++j) *(unsigned*)(CMb + (size_t)(row0 + j) * 512 + ch - 2560) = yp[j];
        }
        if (cbk < 20) {
            u32x4 lo4, hi4;
            lo4.x = (yp[0] & 0xffffu) | (yp[1] << 16); lo4.y = (yp[2] & 0xffffu) | (yp[3] << 16); lo4.z = (yp[4] & 0xffffu) | (yp[5] << 16); lo4.w = (yp[6] & 0xffffu) | (yp[7] << 16);
            hi4.x = (yp[0] >> 16) | (yp[1] & 0xffff0000u); hi4.y = (yp[2] >> 16) | (yp[3] & 0xffff0000u); hi4.z = (yp[4] >> 16) | (yp[5] & 0xffff0000u); hi4.w = (yp[6] >> 16) | (yp[7] & 0xffff0000u);
            *(LAS u32x4*)(tl + c2 * 72 + tg * 8) = lo4; *(LAS u32x4*)(tl + (c2 + 1) * 72 + tg * 8) = hi4;
        }
        __syncthreads();
        if (cbk < 20) {
#pragma unroll
            for (int e = 0; e < 2; ++e) { const int pc = tid + 512 * e, rowc = pc >> 3, part = pc & 7; const u32x4 v = *(const LAS u32x4*)(tl + rowc * 72 + part * 8);
                bf16* dst = cbk < 16 ? XT + (size_t)(cbk * 128 + rowc) * M : BMT + (size_t)((cbk - 16) * 128 + rowc) * M;
                *(u32x4*)(dst + tb * 64 + part * 8) = v; }
        }
    }
}
__device__ __forceinline__ void ssd_unit(Frame& F, bool latent, int uid, const float* DT, const float* PCS, const bf16* XT, const bf16* BMb, const bf16* CMb, const bf16* BMT,
                                         const float* state_in, float* state_out, bf16* Y, const float* dsk) {
    constexpr int S1 = 136, S2 = 72;
    LAS bf16* cmS = (LAS bf16*)F.lds;
    LAS bf16* bmS = cmS + 64 * S1;
    LAS bf16* bmT = bmS + 64 * S1;
    LAS bf16* xTb = bmT + 128 * S2;
    LAS bf16* xTw = xTb + 2 * 64 * S2;
    LAS bf16* Mtb = xTw + 2 * 64 * S2;
    LAS bf16* Sbb = Mtb + 2 * 64 * S2;
    LAS float* Pc = (LAS float*)(Sbb + 2 * 64 * S1);
    LAS float* dtv = Pc + 128; LAS float* wv = dtv + 128; LAS float* ep = wv + 128; LAS float* misc = ep + 128;
    const int tid = F.tid, lane = F.lane, w = F.wave, r = lane & 15, g4 = lane >> 4;
    const int dir = uid & 1, hp = (uid >> 1) & 15, b = uid >> 5, hd0 = 2 * hp, grp = hd0 >> 3;
    const int T = latent ? 1024 : 256, nch = T / 64, seqbase = latent ? NCTX + b * 1024 : b * 256;
    const float dk0 = dsk[hd0], dk1 = dsk[hd0 + 1];
    f32x4 S[2][4];
    __syncthreads();
#pragma unroll
    for (int hh = 0; hh < 2; ++hh)
#pragma unroll
        for (int pt = 0; pt < 4; ++pt) {
            if (latent) S[hh][pt] = *(const f32x4*)(state_in + ((size_t)((b * 2 + dir) * 32 + hd0 + hh) * 64 + 16 * pt + r) * 128 + 16 * w + 4 * g4);
            else S[hh][pt] = (f32x4){0.f, 0.f, 0.f, 0.f};
            u32x2 o; o.x = pk2(S[hh][pt][0], S[hh][pt][1]); o.y = pk2(S[hh][pt][2], S[hh][pt][3]); *(LAS u32x2*)(Sbb + hh * 64 * S1 + (16 * pt + r) * S1 + 16 * w + 4 * g4) = o; }
    u32x4 pcm[2], pbm[2], pbt[2], pxt[2]; float pdt = 0.f, ppc = 0.f;
#define SSD_LOAD(c_) do { const int cc_ = dir == 0 ? (c_) : nch - 1 - (c_); const int rg_ = seqbase + cc_ * 64; \
        _Pragma("unroll") for (int e = 0; e < 2; ++e) { const int pc = tid + 512 * e, row = pc >> 4, c8 = (pc & 15) * 8; \
            pcm[e] = *(const u32x4*)(CMb + (size_t)(rg_ + row) * 512 + grp * 128 + c8); pbm[e] = *(const u32x4*)(BMb + (size_t)(rg_ + row) * 512 + grp * 128 + c8); } \
        _Pragma("unroll") for (int e = 0; e < 2; ++e) { const int pc = tid + 512 * e, row = pc >> 3, c8 = (pc & 7) * 8; pbt[e] = *(const u32x4*)(BMT + (size_t)(grp * 128 + row) * M + rg_ + c8); } \
        _Pragma("unroll") for (int e = 0; e < 2; ++e) { const int pc = tid + 512 * e, row = pc >> 3, c8 = (pc & 7) * 8; pxt[e] = *(const u32x4*)(XT + (size_t)(hd0 * 64 + row) * M + rg_ + c8); } \
        if (w < 2) { const size_t di_ = (size_t)(rg_ + (tid & 63)) * 64 + dir * 32 + hd0 + ((tid >> 6) & 1); pdt = DT[di_]; ppc = PCS[di_]; } } while (0)
    SSD_LOAD(0);
#define SSD_STAGE() do { \
        _Pragma("unroll") for (int e = 0; e < 2; ++e) { const int pc = tid + 512 * e, row = pc >> 4, c8 = (pc & 15) * 8; \
            *(LAS u32x4*)(cmS + row * S1 + c8) = pcm[e]; *(LAS u32x4*)(bmS + row * S1 + c8) = pbm[e]; } \
        _Pragma("unroll") for (int e = 0; e < 2; ++e) { const int pc = tid + 512 * e, row = pc >> 3, c8 = (pc & 7) * 8; *(LAS u32x4*)(bmT + row * S2 + c8) = pbt[e]; *(LAS u32x4*)(xTb + row * S2 + c8) = pxt[e]; } \
        { const float tot = __shfl(ppc, dir == 0 ? 63 : 0); \
          if (w < 2) { Pc[tid] = ppc; dtv[tid] = pdt; wv[tid] = __expf(tot - ppc) * pdt; ep[tid] = __expf(ppc); if (lane == 0) misc[w] = __expf(tot); } } } while (0)
    SSD_STAGE();
    if (1 < nch) SSD_LOAD(1);
    for (int c = 0; c < nch; ++c) {
        const int cc = dir == 0 ? c : nch - 1 - c, rowg = seqbase + cc * 64;
        __syncthreads();
        { const int ti = w >> 1;
#pragma unroll
          for (int jj = 0; jj < 2; ++jj) { const int tj = 2 * (w & 1) + jj; f32x4 a = {0.f, 0.f, 0.f, 0.f};
#pragma unroll
              for (int k4 = 0; k4 < 4; ++k4) { const bf16x8 af = *(const LAS bf16x8*)(bmS + (16 * tj + r) * S1 + 32 * k4 + 8 * g4), bf = *(const LAS bf16x8*)(cmS + (16 * ti + r) * S1 + 32 * k4 + 8 * g4);
                  a = __builtin_amdgcn_mfma_f32_16x16x32_bf16(af, bf, a, 0, 0, 0); }
              const int tau = 16 * ti + r;
#pragma unroll
              for (int hh = 0; hh < 2; ++hh) { const float pt_ = Pc[hh * 64 + tau]; const f32x4 pp = *(const LAS f32x4*)(Pc + hh * 64 + 16 * tj + 4 * g4), dd = *(const LAS f32x4*)(dtv + hh * 64 + 16 * tj + 4 * g4); float mv[4];
#pragma unroll
                  for (int e = 0; e < 4; ++e) { const int tp = 16 * tj + 4 * g4 + e; const bool ok = dir == 0 ? (tp <= tau) : (tp >= tau);
                      mv[e] = ok ? a[e] * __expf(pt_ - pp[e]) * dd[e] : 0.f; }
                  u32x2 o; o.x = pk2(mv[0], mv[1]); o.y = pk2(mv[2], mv[3]); *(LAS u32x2*)(Mtb + hh * 64 * S2 + tau * S2 + 16 * tj + 4 * g4) = o; } } }
#pragma unroll
        for (int e = 0; e < 2; ++e) { const int pc = tid + 512 * e, row = pc >> 3, c8 = (pc & 7) * 8, hh = row >> 6;
            const u32x4 xv = *(const LAS u32x4*)(xTb + row * S2 + c8); const f32x4 w0 = *(const LAS f32x4*)(wv + hh * 64 + c8), w1 = *(const LAS f32x4*)(wv + hh * 64 + c8 + 4);
            u32x4 o; o.x = pk2(bflo(xv.x) * w0[0], bfhi(xv.x) * w0[1]); o.y = pk2(bflo(xv.y) * w0[2], bfhi(xv.y) * w0[3]); o.z = pk2(bflo(xv.z) * w1[0], bfhi(xv.z) * w1[1]); o.w = pk2(bflo(xv.w) * w1[2], bfhi(xv.w) * w1[3]);
            *(LAS u32x4*)(xTw + row * S2 + c8) = o; }
        __syncthreads();
        { const int hh = w >> 2, ti = w & 3, tau = 16 * ti + r; const float epv = ep[hh * 64 + tau];
          const LAS bf16* xT = xTb + hh * 64 * S2; const LAS bf16* Mt = Mtb + hh * 64 * S2; const LAS bf16* Sb = Sbb + hh * 64 * S1;
#pragma unroll
          for (int pt = 0; pt < 4; ++pt) { f32x4 ad = {0.f, 0.f, 0.f, 0.f}, ao = {0.f, 0.f, 0.f, 0.f};
#pragma unroll
              for (int k2 = 0; k2 < 2; ++k2) { const bf16x8 af = *(const LAS bf16x8*)(xT + (16 * pt + r) * S2 + 32 * k2 + 8 * g4), bf = *(const LAS bf16x8*)(Mt + tau * S2 + 32 * k2 + 8 * g4);
                  ad = __builtin_amdgcn_mfma_f32_16x16x32_bf16(af, bf, ad, 0, 0, 0); }
#pragma unroll
              for (int k4 = 0; k4 < 4; ++k4) { const bf16x8 af = *(const LAS bf16x8*)(Sb + (16 * pt + r) * S1 + 32 * k4 + 8 * g4), bf = *(const LAS bf16x8*)(cmS + tau * S1 + 32 * k4 + 8 * g4);
                  ao = __builtin_amdgcn_mfma_f32_16x16x32_bf16(af, bf, ao, 0, 0, 0); }
              { f32x4 yv = ad + ao * epv;
                if (dir == 0) { const float dk = hh == 0 ? dk0 : dk1;
#pragma unroll
                    for (int e = 0; e < 4; ++e) yv[e] += dk * bf2f(xT[(16 * pt + 4 * g4 + e) * S2 + tau]); }
                u32x2 o; o.x = pk2(yv[0], yv[1]); o.y = pk2(yv[2], yv[3]); *(u32x2*)(Y + ((size_t)dir * M + rowg + tau) * 2048 + (hd0 + hh) * 64 + 16 * pt + 4 * g4) = o; } } }
#pragma unroll
        for (int hh = 0; hh < 2; ++hh) { const float dec = misc[hh];
#pragma unroll
          for (int pt = 0; pt < 4; ++pt) { f32x4 a = {0.f, 0.f, 0.f, 0.f};
#pragma unroll
              for (int k2 = 0; k2 < 2; ++k2) { const bf16x8 af = *(const LAS bf16x8*)(bmT + (16 * w + r) * S2 + 32 * k2 + 8 * g4), bf = *(const LAS bf16x8*)(xTw + hh * 64 * S2 + (16 * pt + r) * S2 + 32 * k2 + 8 * g4);
                  a = __builtin_amdgcn_mfma_f32_16x16x32_bf16(af, bf, a, 0, 0, 0); }
              S[hh][pt] = S[hh][pt] * dec + a; } }
        __syncthreads();
#pragma unroll
        for (int hh = 0; hh < 2; ++hh)
#pragma unroll
          for (int pt = 0; pt < 4; ++pt) { u32x2 o; o.x = pk2(S[hh][pt][0], S[hh][pt][1]); o.y = pk2(S[hh][pt][2], S[hh][pt][3]); *(LAS u32x2*)(Sbb + hh * 64 * S1 + (16 * pt + r) * S1 + 16 * w + 4 * g4) = o; }
        if (c + 1 < nch) { SSD_STAGE(); if (c + 2 < nch) SSD_LOAD(c + 2); }
    }
#undef SSD_STAGE
#undef SSD_LOAD
    if (!latent) {
#pragma unroll
        for (int hh = 0; hh < 2; ++hh)
#pragma unroll
            for (int pt = 0; pt < 4; ++pt) *(f32x4*)(state_out + ((size_t)((b * 2 + dir) * 32 + hd0 + hh) * 64 + 16 * pt + r) * 128 + 16 * w + 4 * g4) = S[hh][pt];
    }
}
__device__ __forceinline__ void ssd_core_phase(Frame& F, const float* DT, const float* PCS, const bf16* XT, const bf16* BMb, const bf16* CMb, const bf16* BMT, const float* state_in, float* state_out, bf16* Y, const float* dsk) {
    if (F.G == 256) {
        if (F.bid < 64) { ssd_unit(F, true, F.bid, DT, PCS, XT, BMb, CMb, BMT, state_in, state_out, Y, dsk); ssd_unit(F, false, F.bid, DT, PCS, XT, BMb, CMb, BMT, state_in, state_out, Y, dsk); }
        else { for (int j = 0; j < 5; ++j) ssd_unit(F, false, 64 + 5 * (F.bid - 64) + j, DT, PCS, XT, BMb, CMb, BMT, state_in, state_out, Y, dsk); }
    } else {
        for (int u = F.bid; u < 64 + 1024; u += F.G) ssd_unit(F, u < 64, u < 64 ? u : u - 64, DT, PCS, XT, BMb, CMb, BMT, state_in, state_out, Y, dsk);
    }
}
__device__ __forceinline__ void ssd_combine_phase(Frame& F, const bf16* Y, const bf16* Z, const float* gn, bf16* YN) {
    const int gw = F.bid * NWAVES + F.wave, NGW = F.G * NWAVES;
    constexpr int RB = 2;
    for (int base = gw; base < M; base += RB * NGW) {
        u32x2 yf[RB][8], yb[RB][8], zz[RB][8];
#pragma unroll
        for (int k = 0; k < RB; ++k) { const int row = base + k * NGW, rc = row < M ? row : gw;
#pragma unroll
            for (int j = 0; j < 8; ++j) { const int c = 256 * j + 4 * F.lane; yf[k][j] = __builtin_nontemporal_load((const u32x2*)(Y + (size_t)rc * 2048 + c)); yb[k][j] = __builtin_nontemporal_load((const u32x2*)(Y + ((size_t)M + rc) * 2048 + c)); zz[k][j] = __builtin_nontemporal_load((const u32x2*)(Z + (size_t)rc * 2048 + c)); } }
#pragma unroll
        for (int k = 0; k < RB; ++k) { const int row = base + k * NGW; f32x4 y[8]; float ss = 0.f;
#pragma unroll
            for (int j = 0; j < 8; ++j) {
                const f32x4 a = {bflo(yf[k][j].x) + bflo(yb[k][j].x), bfhi(yf[k][j].x) + bfhi(yb[k][j].x), bflo(yf[k][j].y) + bflo(yb[k][j].y), bfhi(yf[k][j].y) + bfhi(yb[k][j].y)};
                const f32x4 z = {bflo(zz[k][j].x), bfhi(zz[k][j].x), bflo(zz[k][j].y), bfhi(zz[k][j].y)};
                f32x4 v; v[0] = a[0] * silu_f(z[0]); v[1] = a[1] * silu_f(z[1]); v[2] = a[2] * silu_f(z[2]); v[3] = a[3] * silu_f(z[3]);
                y[j] = v; ss += (v[0] * v[0] + v[1] * v[1]) + (v[2] * v[2] + v[3] * v[3]); }
            const float rstd = 1.0f / sqrtf(wave_sum(ss) * (1.0f / 2048.0f) + 1e-6f);
            if (row < M) {
#pragma unroll
                for (int j = 0; j < 8; ++j) { const int c = 256 * j + 4 * F.lane; const f32x4 v = y[j] * rstd * *(const f32x4*)(gn + c);
                    u32x2 p; p.x = pk2(v[0], v[1]); p.y = pk2(v[2], v[3]); *(u32x2*)(YN + (size_t)row * 2048 + c) = p; } } }
    }
}

__global__ void __launch_bounds__(NT, 2) fwd_kernel(Args args) {
    extern __shared__ __attribute__((aligned(16))) unsigned char lds_raw[];
    Frame F;
    F.lds = (LAS unsigned char*)lds_raw;
    F.tid = threadIdx.x; F.lane = F.tid & 63; F.wave = __builtin_amdgcn_readfirstlane(F.tid >> 6);
    F.G = gridDim.x; F.bid = blockIdx.x;
    F.in = args.in; F.out = args.out; F.ws = args.ws;
    unsigned char* ws = args.ws;
    for (int u = F.tid; u < (LDS_BYTES - LDSCTL_OFF) / 4; u += NT) ((LAS unsigned*)(F.lds + LDSCTL_OFF))[u] = 0u;
    __syncthreads();
    volatile LAS unsigned* MISC = (volatile LAS unsigned*)(F.lds + MISC_OFF);
    unsigned* ctl = (unsigned*)(ws + WS_CTL);
    XcdBarrier bar; bar.bar = ctl + CW_BAR; bar.x = 0; bar.st = nullptr;
    if (!MK_PER_PHASE) bar = xcd_barrier_post(ctl + CW_BAR, MISC + 8);
    const int lo = args.ph_lo, hi = args.ph_hi;
    int ph = 0;
#ifndef PROBE_MASK
#define PROBE_MASK 0ull
#endif
#ifndef PROBE_BARX
#define PROBE_BARX 0
#define PROBE_ALLCONV 0
#endif
#ifdef DBG_ONLY
#define PHASE_GUARD (ph == DBG_ONLY && lo <= ph && ph < hi)
#else
#define PHASE_GUARD (lo <= ph && ph < hi)
#endif
#define PHASE(...) { if (PHASE_GUARD) { \
        if (((unsigned long long)(PROBE_MASK) >> ph) & 1ull) { const float rc_ = 0.0f; (void)rc_; asm volatile("" : "+v"(F.tid), "+v"(F.lane)); __VA_ARGS__; if (!MK_PER_PHASE) xcd_barrier(bar); } \
        { const float rc_ = 1.0f; (void)rc_; asm volatile("" : "+v"(F.tid), "+v"(F.lane)); __VA_ARGS__; } \
        if (!MK_PER_PHASE && ph + 1 < hi) { xcd_barrier(bar); if (PROBE_BARX) xcd_barrier(bar); } } ++ph; }

    float* MOD = (float*)(ws + WS_MOD);
    bf16* X = (bf16*)(ws + WS_X);
    bf16* H = (bf16*)(ws + WS_H);
    bf16* HID = (bf16*)(ws + WS_HID);
    float* SSQ0 = (float*)(ws + WS_CTL + 512 * 1024); float* SSQ1 = SSQ0 + 16384; const float* SWB = (const float*)(ws + WS_SW);
    const float* const* in = args.in;

    PHASE( p0_phase(F); )
    PHASE( first_norm_phase(F, in[0], in[1], X, in[8], MOD + D, H, SSQ0); )

#define RUN_GEMM(gid, Aptr, Bptr, NN, KK, ...) { pg8::Gemm g{Aptr, Bptr, M, NN, KK}; pg8::TileOrder S; __VA_ARGS__; S.init(M, NN, F.G, F.bid, decltype(E)::HALF_OK, (gid) == 16); pg8::gemm_phase(F.lds, g, S, E, F.tid); }
#define IDLE_CONV(grp) if ((grp) >= 0 && rc_ == 1.0f) {   \
        if (F.G == 256 && !PROBE_ALLCONV) { if (F.bid >= 160) conv_group<((grp) >= 0 ? (grp) : 15)>(F, (F.bid - 160) * NWAVES + F.wave, 96 * NWAVES); } \
        else { conv_group<((grp) >= 0 ? (grp) : 15)>(F, F.bid * NWAVES + F.wave, F.G * NWAVES); __syncthreads(); } }
#define SSQ_R(p) ((p) % 2 == 0 ? SSQ0 : SSQ1)
#define SSQ_W(p) ((p) % 2 == 0 ? SSQ1 : SSQ0)
#define ZERO_SSQ(p) { if (F.bid < 40) { float* z_ = SSQ_W(p) + F.bid * 256; if (F.tid < 256) z_[F.tid] = 0.f; } }
#define FFN_BLOCK(l, half, grp) { \
    constexpr int sub_ = (half) == 0 ? 0 : 2; constexpr int pr_ = 3 * (l) + ((half) == 0 ? 0 : 2); const float* modl_ = MOD + (size_t)(l) * 3 * NMOD; \
    PHASE( { ZERO_SSQ(pr_) \
        RUN_GEMM(((l) * 2 + (half)) * 2, H, (const bf16*)(ws + WS_WFI) + (size_t)((l) * 2 + (half)) * 5632 * 1024, 5632, 1024, EpiSwiglu E{HID, SSQ_R(pr_), SWB + (size_t)((l) * 2 + (half)) * 3 * SWN, F.lds}) } \
    ) \
    PHASE( { IDLE_CONV(grp) \
        constexpr int ln_ = (half) == 0 ? (l) : (l) + 1, sn_ = (half) == 0 ? 1 : 0; \
        RUN_GEMM(((l) * 2 + (half)) * 2 + 1, HID, (const bf16*)(ws + WS_WFO) + (size_t)((l) * 2 + (half)) * 1024 * 2816, 1024, 2816, \
                 EpiResid<(ln_ < 4)> E{X, modl_ + (size_t)(3 * sub_ + 2) * D, in[8] + (size_t)((ln_ < 4 ? ln_ : 0) * 3 + sn_) * D, MOD + (size_t)(ln_ < 4 ? ln_ : 0) * 3 * NMOD + (size_t)(3 * sn_ + 1) * D, H, SSQ_W(pr_), F.lds, F.G >= 160, 0.5f * rc_, rc_}) } \
    ) }

#define OUT_GEMM(l, Aptr, Wptr, KK, grp) PHASE( { IDLE_CONV(grp) \
        RUN_GEMM(17 + 2 * (l), Aptr, Wptr, 1024, KK, EpiResid<true> E{X, MOD + (size_t)(l) * 3 * NMOD + 5 * D, in[8] + (size_t)((l) * 3 + 2) * D, MOD + (size_t)(l) * 3 * NMOD + 7 * D, H, SSQ_W(3 * (l) + 1), F.lds, F.G >= 160, rc_, rc_}) } )
    unsigned char* R = ws + WS_R;
    float* out = args.out;

    FFN_BLOCK(0, 0, 1)
    {
        bf16* PROJ = (bf16*)R; bf16* O = (bf16*)(R + 130 * MiB); bf16* Gb = (bf16*)(R + 210 * MiB);
        PHASE( { ZERO_SSQ(1) RUN_GEMM(16, H, (const bf16*)(ws + WS_WGI), GLA_NP, 1024, EpiBf16Plain E{PROJ, GLA_NP, SSQ_R(1), SWB + (size_t)8 * 3 * SWN}) } )
        PHASE( gla_prep_phase(F, PROJ, R + 232 * MiB, in[15], in[16], (const float*)(ws + WS_ROPE), (const float*)(ws + WS_ROPE) + 65536); )
        PHASE( gla_core_phase(F, PROJ, R + 232 * MiB, O, in[2], out + 10485760); )
        PHASE( gla_combine_phase(F, PROJ, O, in[17], Gb); )
        OUT_GEMM(0, Gb, (const bf16*)(ws + WS_WGO), 1024, 2)
    }
    FFN_BLOCK(0, 1, 3)
    FFN_BLOCK(1, 0, 4)
    {
        bf16* Qb = (bf16*)R; bf16* Kb = (bf16*)(R + 20 * MiB); bf16* VTC = (bf16*)(R + 40 * MiB); bf16* VTL = (bf16*)(R + 56 * MiB); bf16* ATT = (bf16*)(R + 60 * MiB);
        PHASE( { ZERO_SSQ(4) RUN_GEMM(18, H, (const bf16*)(ws + WS_WNI), 3072, 1024, EpiNatQKV E{Qb, Kb, VTC, VTL, out + 18874368, out + 27262976, SSQ_R(4), SWB + (size_t)9 * 3 * SWN}) } )
        PHASE( nat_attn_phase(F, Qb, Kb, VTC, VTL, (const bf16*)(ws + WS_CK), (const bf16*)(ws + WS_CVT), in[20], ATT); )
        OUT_GEMM(1, ATT, (const bf16*)(ws + WS_WNO), 1024, 5)
    }
    FFN_BLOCK(1, 1, 6)
    FFN_BLOCK(2, 0, 7)
    {
        bf16* Ub = (bf16*)R; bf16* Vf = (bf16*)(R + 20 * MiB); bf16* VN = (bf16*)(R + 60 * MiB); bf16* MX = (bf16*)(R + 80 * MiB);
        float* LN1 = (float*)(ws + WS_CTL + 640 * 1024); float* LN2 = LN1 + 16384;
        PHASE( { ZERO_SSQ(7) RUN_GEMM(20, H, (const bf16*)(ws + WS_WMI), 2048, 1024, EpiGmlpIn E{Ub, Vf, SSQ_R(7), SWB + (size_t)10 * 3 * SWN, LN1, LN2, rc_}) } )
        PHASE( gm_spatial_phase(F, Vf, LN1, LN2, in[23], in[24], Ub, in[25], in[26], MX); )
        OUT_GEMM(2, MX, (const bf16*)(ws + WS_WMO), 1024, 8)
    }
    FFN_BLOCK(2, 1, 9)
    FFN_BLOCK(3, 0, -1)
    {
        bf16* XBC = (bf16*)R; float* DT = (float*)(R + 60 * MiB); bf16* Zb = (bf16*)(R + 104 * MiB); float* DTS = (float*)(R + 144 * MiB); float* PCS = (float*)(R + 147 * MiB); bf16* XT = (bf16*)(R + 187 * MiB);
        bf16* BMb = (bf16*)(R + 227 * MiB); bf16* CMb = (bf16*)(R + 237 * MiB); bf16* BMT = (bf16*)(R + 247 * MiB); bf16* YN = (bf16*)(R + 257 * MiB);
        bf16* Y = (bf16*)(ws + WS_HID);
        PHASE( { ZERO_SSQ(10) RUN_GEMM(22, H, (const bf16*)(ws + WS_WSI), SSD_NP, 1024, EpiSsdIn E{Zb, XBC, DT, SSQ_R(10), SWB + (size_t)11 * 3 * SWN}) } )
        PHASE( ssd_conv_phase(F, XBC, DT, DTS, PCS, in[32], in[29], in[30], in[31], XT, BMb, CMb, BMT); )
        PHASE( ssd_core_phase(F, DTS, PCS, XT, BMb, CMb, BMT, in[5], out + 35651584, Y, in[33]); )
        PHASE( ssd_combine_phase(F, Y, Zb, in[34], YN); )
        OUT_GEMM(3, YN, (const bf16*)(ws + WS_WSO), 2048, -1)
    }
    FFN_BLOCK(3, 1, -1)
    PHASE( final_norm_phase(F, X, in[36], F.out); )
}

constexpr int N_PHASES = 2 + 9 + 7 + 7 + 9 + 1;

extern "C" void kernel_launch(void* const* d_in, const int* in_sizes, int n_in, void* d_out, int out_size, void* d_ws, size_t ws_size, hipStream_t stream) {
    static int grid = 0;
    if (grid == 0) {
        if (n_in != 37 || ws_size < WS_END) { fprintf(stderr, "kernel_launch: unexpected n_in %d / ws %zu\n", n_in, ws_size); grid = -1; return; }
        int dev = 0, cus = 0;
        if (hipGetDevice(&dev) != hipSuccess || hipDeviceGetAttribute(&cus, hipDeviceAttributeMultiprocessorCount, dev) != hipSuccess) { grid = -1; return; }
        if (hipFuncSetAttribute((const void*)fwd_kernel, hipFuncAttributeMaxDynamicSharedMemorySize, LDS_BYTES) != hipSuccess) { fprintf(stderr, "kernel_launch: hipFuncSetAttribute failed\n"); grid = -1; return; }
        int per_cu = 0;
        if (hipOccupancyMaxActiveBlocksPerMultiprocessor(&per_cu, (const void*)fwd_kernel, NT, LDS_BYTES) != hipSuccess || per_cu < 1) fprintf(stderr, "kernel_launch: occupancy query says %d\n", per_cu);
        (void)hipGetLastError();
        grid = cus;
    }
    if (grid < 0) return;
    (void)hipMemsetAsync((char*)d_ws + WS_CTL, 0, CTL_ZERO_BYTES, stream);
    Args a{};
    for (int i = 0; i < 37; ++i) a.in[i] = (const float*)d_in[i];
    a.out = (float*)d_out; a.ws = (unsigned char*)d_ws;
#if MK_PER_PHASE
    for (int p = 0; p < N_PHASES; ++p) { a.ph_lo = p; a.ph_hi = p + 1; hipLaunchKernelGGL(fwd_kernel, dim3(grid), dim3(NT), LDS_BYTES, stream, a); }
#else
    a.ph_lo = 0; a.ph_hi = N_PHASES;
    hipLaunchKernelGGL(fwd_kernel, dim3(grid), dim3(NT), LDS_BYTES, stream, a);
#endif
}
```
